# Optimizing an MI355X kernel written in HIP

```python
import math
import jax, jax.numpy as jnp
from jax import lax
import numpy as np

D_MODEL = 1024
BATCH = 4
SEQ = 8192
DEPTH = 2

GRID_W = 64
CTX_LEN = 256
N_MIXERS = 2
FF_HIDDEN = 2816
RW_HEAD = 64
RW_HEADS = D_MODEL // RW_HEAD
DECAY_LORA = 64
AAA_LORA = 64
GATE_LORA = 160
HY_N_FILT = 2
HY_BANDS = 16
HY_EMB = 2 * HY_BANDS + 1
HY_HID = 64
HY_FAST_DECAY = 0.3
HY_SLOW_DECAY = 1.5
HY_TARGET = 1e-2
NORM_EPS = 1e-6
GN_EPS = 64e-5
N_RWKV = (DEPTH + N_MIXERS - 1) // N_MIXERS
N_HYENA = DEPTH // N_MIXERS

kernel_name = 'hybrid_rwkv7_hyena_diffusion_block'

F32 = jnp.float32


def _rmsnorm(x, g):
    x32 = x.astype(F32)
    y = x32 * lax.rsqrt(jnp.mean(x32 * x32, axis=-1, keepdims=True) + NORM_EPS) * g.astype(F32)
    return y.astype(x.dtype)


def _pre(x, g, shift, scale):
    return _rmsnorm(x, g) * (1 + scale) + shift


def _swiglu(h, w_gu, w_down):
    gate, up = jnp.split(h @ w_gu, 2, axis=-1)
    return (jax.nn.silu(gate) * up) @ w_down


def _grid_shift(h):
    B, T, D = h.shape
    rows = T // GRID_W
    q = D // 4
    g = jnp.pad(h.reshape(B, rows, GRID_W, D), ((0, 0), (1, 1), (1, 1), (0, 0)))
    out = jnp.concatenate([g[:, 1:-1, :-2, :q], g[:, 1:-1, 2:, q:2 * q],
                           g[:, :-2, 1:-1, 2 * q:3 * q], g[:, 2:, 1:-1, 3 * q:]], axis=-1)
    return out.reshape(B, T, D)


def _seq_shift(h):
    q = h.shape[-1] // 4
    p = jnp.pad(h, ((0, 0), (1, 1), (0, 0)))
    prev, nxt = p[:, :-2], p[:, 2:]
    return jnp.concatenate([prev[..., :q], nxt[..., q:2 * q], prev[..., 2 * q:3 * q], nxt[..., 3 * q:]], axis=-1)


def _both(a):
    return jnp.stack([a, jnp.flip(a, axis=1)])


def _fb(a):
    return jnp.stack([a[0], jnp.flip(a[1], axis=1)])


def _wkv_scan(S0, w, k, v, kk, ka, r=None):
    tm = lambda a: jnp.moveaxis(a, 2, 0)
    xs = (tm(w), tm(k), tm(v), tm(kk), tm(ka)) + (() if r is None else (tm(r),))

    def step(S, inp):
        w_t, k_t, v_t, kk_t, ka_t = inp[:5]
        sa = jnp.einsum('dbhvk,dbhk->dbhv', S, kk_t)
        S = S * w_t[..., None, :] - sa[..., None] * ka_t[..., None, :] + v_t[..., None] * k_t[..., None, :]
        if r is None:
            return S, None
        return S, jnp.einsum('dbhvk,dbhk->dbhv', S, inp[5])

    S, y = lax.scan(step, S0, xs)
    return S, (None if y is None else jnp.moveaxis(y, 0, 2))


def _rwkv7_sequence(h, shifted, S0, p, with_out):
    (mix, w_rkv, w_o, w0, w1, w2, a0, a1, a2, g1, g2, k_k, k_a, r_k, ln_g, ln_b) = p
    B, T, D = h.shape
    heads = lambda a: a.reshape(a.shape[:-1] + (RW_HEADS, RW_HEAD)).astype(F32)
    xm = h[None] + (shifted - h)[None] * mix[:, None, None, :]
    xr, xw, xk, xv, xa, xg = xm
    k = xk @ w_rkv[1]
    vh = heads(xv @ w_rkv[2])
    w_pre = w0[:, None, None, :] + jnp.einsum('nbtr,nrd->nbtd', jnp.tanh(jnp.einsum('btd,ndr->nbtr', xw, w1)), w2)
    decay = jnp.exp(-jnp.exp(-jax.nn.softplus(-w_pre.astype(F32)) - 0.5))
    a = jax.nn.sigmoid((a0[:, None, None, :] + jnp.einsum('nbtr,nrd->nbtd', jnp.einsum('btd,ndr->nbtr', xa, a1), a2)).astype(F32))
    ah = heads(a)
    kk = heads(k * k_k)
    kk = kk / jnp.maximum(jnp.sqrt(jnp.sum(kk * kk, axis=-1, keepdims=True)), 1e-12)
    k_dir = heads(k)[None] * (1 + (ah - 1) * heads(k_a))
    ka = kk[None] * ah
    rh = heads(xr @ w_rkv[0]) if with_out else None
    S, y = _wkv_scan(S0, _fb(heads(decay)), _fb(k_dir), _both(vh), _both(kk), _fb(ka),
                     None if rh is None else _both(rh))
    if not with_out:
        return None, S
    y = y[0] + jnp.flip(y[1], axis=1)
    mu = jnp.mean(y, axis=-1, keepdims=True)
    var = jnp.mean(jnp.square(y - mu), axis=-1, keepdims=True)
    y = (y - mu) * lax.rsqrt(var + GN_EPS) * heads(ln_g) + heads(ln_b)
    k_bonus = 0.5 * (k_dir[0] + k_dir[1])
    y = y + jnp.sum(rh * k_bonus * r_k.astype(F32), axis=-1, keepdims=True) * vh
    g = jax.nn.sigmoid(xg @ g1) @ g2
    return (y.reshape(B, T, D).astype(h.dtype) * g) @ w_o, S


def _conv3(u, w, b):
    up = jnp.pad(u, ((0, 0), (1, 1), (0, 0)))
    return up[:, :-2] * w[0] + up[:, 1:-1] * w[1] + up[:, 2:] * w[2] + b


def _hyena_filters(L, f_w1, f_b1, f_freq, f_w2, f_b2, f_w3, deltas):
    f32 = lambda a: a.astype(F32)
    t = jnp.linspace(0.0, 1.0, L, dtype=F32)[:, None]
    ang = (2 * math.pi / L) * jnp.arange(L, dtype=F32)[:, None] * jnp.linspace(1e-4, HY_BANDS - 1, HY_BANDS, dtype=F32)[None]
    z = jnp.concatenate([t, jnp.cos(ang), -jnp.sin(ang)], axis=-1)
    hid = jnp.sin(f32(f_freq[0]) * (z @ f32(f_w1) + f32(f_b1)))
    hid = jnp.sin(f32(f_freq[1]) * (hid @ f32(f_w2) + f32(f_b2)))
    filt = (hid @ f32(f_w3)).reshape(L, HY_N_FILT, -1)
    return filt * jnp.exp(-t[:, :, None] * jnp.abs(f32(deltas)))


def _fftconv(u, filt, bias):
    L = u.shape[1]
    n = 2 * L
    y = jnp.fft.irfft(jnp.fft.rfft(u, n=n, axis=1) * jnp.fft.rfft(filt, n=n, axis=0)[None], n=n, axis=1)[:, :L]
    return y + u * bias.astype(F32)


def _hyena_sequence(h, p):
    (w_in, conv_w, conv_b, f_w1, f_b1, f_freq, f_w2, f_b2, f_w3, deltas, bias, w_out) = p
    L = h.shape[1]
    u = _conv3(h @ w_in, conv_w, conv_b).astype(F32)
    x1, x2, v = jnp.split(u, 3, axis=-1)
    filt = _hyena_filters(L, f_w1, f_b1, f_freq, f_w2, f_b2, f_w3, deltas)
    z = x1 * _fftconv(v, filt[:, 0], bias[0])
    z = x2 * _fftconv(z, filt[:, 1], bias[1])
    return z.astype(h.dtype) @ w_out


def setup_inputs(seed: int = 0) -> dict:
    key = jax.random.key(seed)
    ks = iter(jax.random.split(key, 64))
    nrm = lambda shape, s: jax.random.normal(next(ks), shape, F32) * s
    uni = lambda shape, lo, hi: jax.random.uniform(next(ks), shape, F32, lo, hi)
    D, F, NR, NH = D_MODEL, FF_HIDDEN, N_RWKV, N_HYENA
    max_decay = math.log(HY_TARGET) / HY_FAST_DECAY
    min_decay = math.log(HY_TARGET) / HY_SLOW_DECAY
    deltas = jnp.broadcast_to(jnp.linspace(min_decay, max_decay, D, dtype=F32), (NH, HY_N_FILT, D)) + nrm((NH, HY_N_FILT, D), 0.05)
    return {
        'x': nrm((BATCH, SEQ, D), 1.0),
        'c': nrm((BATCH, D), 1.0),
        'ctx': nrm((BATCH, CTX_LEN, D), 1.0),
        'c_ctx': nrm((D,), 1.0),
        'mod_w': nrm((DEPTH, D, 9 * D), 0.5 * D ** -0.5),
        'mod_b': nrm((DEPTH, 9 * D), 0.02),
        'norm_g': 1.0 + nrm((DEPTH, 3, D), 0.02),
        'ffn_w_gu': nrm((DEPTH, 2, D, 2 * F), D ** -0.5),
        'ffn_w_down': nrm((DEPTH, 2, F, D), F ** -0.5),
        'rw_mix': uni((NR, 6, D), 0.0, 1.0),
        'rw_w_rkv': nrm((NR, 3, D, D), D ** -0.5),
        'rw_w_o': nrm((NR, D, D), D ** -0.5),
        'rw_w0': uni((NR, 2, D), -6.5, -1.0),
        'rw_w1': nrm((NR, 2, D, DECAY_LORA), D ** -0.5),
        'rw_w2': nrm((NR, 2, DECAY_LORA, D), 0.5 * DECAY_LORA ** -0.5),
        'rw_a0': nrm((NR, 2, D), 0.1),
        'rw_a1': nrm((NR, 2, D, AAA_LORA), D ** -0.5),
        'rw_a2': nrm((NR, 2, AAA_LORA, D), 0.5 * AAA_LORA ** -0.5),
        'rw_g1': nrm((NR, D, GATE_LORA), D ** -0.5),
        'rw_g2': nrm((NR, GATE_LORA, D), GATE_LORA ** -0.5),
        'rw_k_k': 0.85 + nrm((NR, D), 0.02),
        'rw_k_a': 1.0 + nrm((NR, D), 0.02),
        'rw_r_k': nrm((NR, RW_HEADS, RW_HEAD), 0.1),
        'rw_ln_g': 1.0 + nrm((NR, D), 0.02),
        'rw_ln_b': nrm((NR, D), 0.02),
        'hy_w_in': nrm((NH, D, 3 * D), D ** -0.5),
        'hy_conv_w': nrm((NH, 3, 3 * D), 3 ** -0.5),
        'hy_conv_b': nrm((NH, 3 * D), 0.02),
        'hy_f_w1': nrm((NH, HY_EMB, HY_HID), HY_EMB ** -0.5),
        'hy_f_b1': nrm((NH, HY_HID), 0.1),
        'hy_f_freq': 1.0 + nrm((NH, 2, HY_HID), 0.02),
        'hy_f_w2': nrm((NH, HY_HID, HY_HID), HY_HID ** -0.5),
        'hy_f_b2': nrm((NH, HY_HID), 0.1),
        'hy_f_w3': nrm((NH, HY_HID, HY_N_FILT * D), 0.003),
        'hy_deltas': deltas,
        'hy_bias': nrm((NH, HY_N_FILT, D), 0.1),
        'hy_w_out': nrm((NH, D, D), D ** -0.5),
        'final_g': 1.0 + nrm((D,), 0.02),
    }


def reference(x, c, ctx, c_ctx, mod_w, mod_b, norm_g, ffn_w_gu, ffn_w_down,
              rw_mix, rw_w_rkv, rw_w_o, rw_w0, rw_w1, rw_w2, rw_a0, rw_a1, rw_a2, rw_g1, rw_g2,
              rw_k_k, rw_k_a, rw_r_k, rw_ln_g, rw_ln_b,
              hy_w_in, hy_conv_w, hy_conv_b, hy_f_w1, hy_f_b1, hy_f_freq, hy_f_w2, hy_f_b2, hy_f_w3,
              hy_deltas, hy_bias, hy_w_out, final_g):
    B = x.shape[0]
    rw = (rw_mix, rw_w_rkv, rw_w_o, rw_w0, rw_w1, rw_w2, rw_a0, rw_a1, rw_a2, rw_g1, rw_g2,
          rw_k_k, rw_k_a, rw_r_k, rw_ln_g, rw_ln_b)
    hy = (hy_w_in, hy_conv_w, hy_conv_b, hy_f_w1, hy_f_b1, hy_f_freq, hy_f_w2, hy_f_b2, hy_f_w3,
          hy_deltas, hy_bias, hy_w_out)
    last_rec = ((DEPTH - 1) // N_MIXERS) * N_MIXERS
    xl, xc = x, ctx
    for i in range(DEPTH):
        ctx_live, ctx_full = i <= last_rec, i < last_rec
        ml = [m[:, None, :] for m in jnp.split(jax.nn.silu(c) @ mod_w[i] + mod_b[i], 9, axis=-1)]
        mc = jnp.split(jax.nn.silu(c_ctx) @ mod_w[i] + mod_b[i], 9) if ctx_live else None
        xl = xl + 0.5 * ml[2] * _swiglu(_pre(xl, norm_g[i, 0], ml[0], ml[1]), ffn_w_gu[i, 0], ffn_w_down[i, 0])
        if ctx_live:
            xc = xc + 0.5 * mc[2] * _swiglu(_pre(xc, norm_g[i, 0], mc[0], mc[1]), ffn_w_gu[i, 0], ffn_w_down[i, 0])
        hl = _pre(xl, norm_g[i, 1], ml[3], ml[4])
        hc = _pre(xc, norm_g[i, 1], mc[3], mc[4]) if ctx_live else None
        j = i // N_MIXERS
        if i % N_MIXERS == 0:
            p = tuple(a[j] for a in rw)
            S0 = jnp.zeros((2, B, RW_HEADS, RW_HEAD, RW_HEAD), F32)
            yc, S_ctx = _rwkv7_sequence(hc, _seq_shift(hc), S0, p, ctx_full)
            yl, _ = _rwkv7_sequence(hl, _grid_shift(hl), S_ctx, p, True)
        else:
            p = tuple(a[j] for a in hy)
            yl = _hyena_sequence(hl, p)
            yc = _hyena_sequence(hc, p) if ctx_full else None
        xl = xl + ml[5] * yl
        if ctx_full:
            xc = xc + mc[5] * yc
            xc = xc + 0.5 * mc[8] * _swiglu(_pre(xc, norm_g[i, 2], mc[6], mc[7]), ffn_w_gu[i, 1], ffn_w_down[i, 1])
        xl = xl + 0.5 * ml[8] * _swiglu(_pre(xl, norm_g[i, 2], ml[6], ml[7]), ffn_w_gu[i, 1], ffn_w_down[i, 1])
    return _rmsnorm(xl, final_g)
```

```cpp
#include <hip/hip_runtime.h>
#include <hip/hip_cooperative_groups.h>
#include <cstdio>
namespace cg = cooperative_groups;
namespace pg8 {
#define PG8_LAS __attribute__((address_space(3)))
typedef unsigned short bf16_t;
typedef short bf16x8 __attribute__((ext_vector_type(8)));
typedef float f32x4 __attribute__((ext_vector_type(4)));
typedef unsigned u32x4 __attribute__((ext_vector_type(4)));
constexpr int BM = 256, BK = 64, HALF = 128, HTB = HALF * BK * 2  , STAGE_BYTES = 8 * HTB, NXCD = 8, WGM = 8;

__host__ __device__ __forceinline__ int lds_byte(int r, int c) { const int st = (r >> 4) * 2 + (c >> 5), rr = r & 15, cc = c & 31, ob = rr * 64 + cc * 2; return st * 1024 + (ob ^ (((ob >> 9) & 1) << 5)); }
__host__ __device__ __forceinline__ void stage_rc(int b, int& R, int& C) { const int st = b / 1024, sb = b % 1024, swz = sb ^ (((sb >> 9) & 1) << 5); R = (st >> 1) * 16 + swz / 64; C = (st & 1) * 32 + (swz % 64) / 2; }
__host__ __device__ __forceinline__ int perm32(int rho) { const int n = rho >> 4, i = rho & 15; return 8 * (i >> 2) + 4 * n + (i & 3); }

struct Unit { int pm, pn; };
struct Gemm { const bf16_t* A; const bf16_t* Bt; int M, N, K; };

struct StaticOrder {
    int nM, nN, nwg, G, c;
    __host__ __device__ void init(int M, int N, int G_, int c_) { nM = M / BM; nN = N / BM; nwg = nM * nN; G = G_; c = c_; }
    __host__ __device__ bool next(int i, Unit& u) const {
        const long L = (long)i * G + c; if (L >= nwg) return false;
        int wgid = (int)L; { const int q = nwg / NXCD, r = nwg % NXCD, xcd = wgid % NXCD, off = wgid / NXCD; wgid = (xcd < r ? xcd * (q + 1) : r * (q + 1) + (xcd - r) * q) + off; }
        const int nig = WGM * nN, gid = wgid / nig, fm = gid * WGM, gsz = (nM - fm) < WGM ? (nM - fm) : WGM;
        u.pm = fm + ((wgid % nig) % gsz); u.pn = (wgid % nig) / gsz; return true;
    }
    __device__ __forceinline__ void a_ready(const Unit&) const {}
    __device__ __forceinline__ void done(const Unit&) const {}
};
__device__ __forceinline__ unsigned cvt_pk_bf16(float lo, float hi) { unsigned r; asm volatile("v_cvt_pk_bf16_f32 %0, %1, %2" : "=v"(r) : "v"(lo), "v"(hi)); return r; }
template <class Epi, class Sched, bool STAMP = false>
__device__ __forceinline__ void gemm_phase(PG8_LAS unsigned char* lds, const Gemm g, const Sched& S, const Epi& E, unsigned long long* stamps) {
    int tid_l = threadIdx.x; asm volatile("" : "+v"(tid_l));
    const int tid = tid_l, wid = __builtin_amdgcn_readfirstlane(tid >> 6), lane = tid & 63, wr = wid >> 2, wc = wid & 3, fr = lane & 15, fq = lane >> 4;
    const int K = g.K, nt = K / BK;
    int ts_lo = 0, ts_hi = 0, nts = 0; const unsigned long long rt_entry = STAMP ? (unsigned long long)wall_clock64() : 0ull;
#define PG8_STAMP() do { if (STAMP && wid == 0 && nts < 64) { const unsigned long long _c = (unsigned long long)clock64(); \
        ts_lo = (lane == nts) ? (int)(unsigned)_c : ts_lo; ts_hi = (lane == nts) ? (int)(unsigned)(_c >> 32) : ts_hi; ++nts; } } while (0)
    PG8_STAMP();
    unsigned voffA[2], voffB[2];
#pragma unroll
    for (int i = 0; i < 2; ++i) { int R, C; stage_rc(tid * 16 + i * 8192, R, C); const int Rb = Epi::PERM ? ((R & ~31) + perm32(R & 31)) : R;
        voffA[i] = (unsigned)(R * K + C) * 2u; voffB[i] = (unsigned)(Rb * K + C) * 2u; }
    const size_t kstep = (size_t)(BK * 2);
    const size_t hstep = (size_t)HALF * K * 2;
    const size_t tstep = 2 * hstep;
    const unsigned ldsw = (unsigned)wid * 1024u;
    const int aoff = lds_byte(wr * 64 + fr, fq * 8), boff = lds_byte(wc * 32 + fr, fq * 8);
#define PG8_SA(b, h) (((b) * 2 + (h)) * HTB)
#define PG8_SB(b, h) ((4 + (b) * 2 + (h)) * HTB)
#define PG8_STAGE(bufoff, gbase, voff) do { _Pragma("unroll") for (int _i = 0; _i < 2; ++_i) \
        __builtin_amdgcn_global_load_lds((const unsigned*)((const char*)(gbase) + (voff)[_i]), (PG8_LAS unsigned*)(lds + (bufoff) + ldsw + _i * 8192), 16, 0, 0); } while (0)
#define PG8_LDA(dst, b, h) do { _Pragma("unroll") for (int m = 0; m < 4; ++m) _Pragma("unroll") for (int k = 0; k < 2; ++k) dst[m][k] = *(const PG8_LAS bf16x8*)(lds + PG8_SA(b, h) + aoff + m * 2048 + k * 1024); } while (0)
#define PG8_LDB(dst, b, h) do { _Pragma("unroll") for (int n = 0; n < 2; ++n) _Pragma("unroll") for (int k = 0; k < 2; ++k) dst[n][k] = *(const PG8_LAS bf16x8*)(lds + PG8_SB(b, h) + boff + n * 2048 + k * 1024); } while (0)
#define PG8_MMA(ai, bj, At, Bt) do { __builtin_amdgcn_s_setprio(1); _Pragma("unroll") for (int m = 0; m < 4; ++m) _Pragma("unroll") for (int n = 0; n < 2; ++n) _Pragma("unroll") for (int k = 0; k < 2; ++k) \
        acc[ai][bj][m][n] = __builtin_amdgcn_mfma_f32_16x16x32_bf16(Bt[n][k], At[m][k], acc[ai][bj][m][n], 0, 0, 0); __builtin_amdgcn_s_setprio(0); } while (0)
#define PG8_WAIT_V(n) asm volatile("s_waitcnt vmcnt(" #n ")" ::: "memory")
#define PG8_WAIT_L(n) asm volatile("s_waitcnt lgkmcnt(" #n ")" ::: "memory")
#define PG8_BAR __builtin_amdgcn_s_barrier()
#define PG8_SCHED __builtin_amdgcn_sched_barrier(0)
    Unit cur, nxt; int ui = 0;
    if (!S.next(0, cur)) return;
    f32x4 acc[2][2][4][2];
#pragma unroll
    for (int a = 0; a < 2; ++a)
#pragma unroll
        for (int b = 0; b < 2; ++b)
#pragma unroll
            for (int m = 0; m < 4; ++m)
#pragma unroll
                for (int n = 0; n < 2; ++n) acc[a][b][m][n] = (f32x4){0.f, 0.f, 0.f, 0.f};
    bf16x8 At[4][2], B0[2][2], B1[2][2];
    const char* cA = (const char*)g.A + (size_t)cur.pm * tstep; const char* cB = (const char*)g.Bt + (size_t)cur.pn * tstep;
    S.a_ready(cur);
    PG8_STAGE(PG8_SB(0, 0), cB, voffB); PG8_STAGE(PG8_SA(0, 0), cA, voffA); PG8_STAGE(PG8_SB(0, 1), cB + hstep, voffB); PG8_STAGE(PG8_SA(0, 1), cA + hstep, voffA);
    if (wr == 1) PG8_BAR;
    PG8_WAIT_V(4); PG8_BAR;
    PG8_STAGE(PG8_SB(1, 0), cB + kstep, voffB); PG8_STAGE(PG8_SA(1, 0), cA + kstep, voffA); PG8_STAGE(PG8_SB(1, 1), cB + hstep + kstep, voffB);
    PG8_WAIT_V(6); PG8_BAR;
    PG8_STAMP();
    for (;;) {
        const bool has_next = S.next(ui + 1, nxt);
        const char* nA = has_next ? (const char*)g.A + (size_t)nxt.pm * tstep : cA; const char* nB = has_next ? (const char*)g.Bt + (size_t)nxt.pn * tstep : cB;
        for (int t = 0; t < nt; t += 2) {
            const bool last = (t == nt - 2);
            const char* a1 = cA + (size_t)(t + 1) * kstep;
            const char* a2 = last ? nA : cA + (size_t)(t + 2) * kstep; const char* b2 = last ? nB : cB + (size_t)(t + 2) * kstep;
            const char* a3 = a2 + kstep; const char* b3 = b2 + kstep;
            if (last && has_next) S.a_ready(nxt);
            PG8_LDB(B0, 0, 0); PG8_SCHED; PG8_LDA(At, 0, 0); PG8_STAGE(PG8_SA(1, 1), a1 + hstep, voffA);
            PG8_WAIT_L(8); PG8_BAR; PG8_WAIT_L(0); PG8_MMA(0, 0, At, B0); PG8_BAR; PG8_SCHED;
            PG8_LDB(B1, 0, 1); PG8_STAGE(PG8_SB(0, 0), b2, voffB);
            PG8_BAR; PG8_WAIT_L(0); PG8_MMA(0, 1, At, B1); PG8_BAR;
            PG8_LDA(At, 0, 1); PG8_STAGE(PG8_SA(0, 0), a2, voffA);
            PG8_BAR; PG8_WAIT_L(0); PG8_MMA(1, 0, At, B0); PG8_BAR; PG8_SCHED;
            PG8_STAGE(PG8_SB(0, 1), b2 + hstep, voffB);
            PG8_WAIT_V(6); PG8_BAR; PG8_MMA(1, 1, At, B1); PG8_BAR;
            PG8_LDB(B0, 1, 0); PG8_SCHED; PG8_LDA(At, 1, 0); PG8_STAGE(PG8_SA(0, 1), a2 + hstep, voffA);
            PG8_WAIT_L(8); PG8_BAR; PG8_WAIT_L(0); PG8_MMA(0, 0, At, B0); PG8_BAR; PG8_SCHED;
            PG8_LDB(B1, 1, 1); PG8_STAGE(PG8_SB(1, 0), b3, voffB);
            PG8_BAR; PG8_WAIT_L(0); PG8_MMA(0, 1, At, B1); PG8_BAR;
            PG8_LDA(At, 1, 1); PG8_STAGE(PG8_SA(1, 0), a3, voffA);
            PG8_BAR; PG8_WAIT_L(0); PG8_MMA(1, 0, At, B0); PG8_BAR; PG8_SCHED;
            PG8_STAGE(PG8_SB(1, 1), b3 + hstep, voffB);
            PG8_WAIT_V(6); PG8_BAR; PG8_MMA(1, 1, At, B1); PG8_BAR;
        }
        PG8_STAMP();
        if constexpr (!Epi::AFTER_DRAIN) { E(acc, cur, wr, wc, fr, fq); S.done(cur); }
        PG8_STAMP();
        if (!has_next) break;
#pragma unroll
        for (int a = 0; a < 2; ++a)
#pragma unroll
            for (int b = 0; b < 2; ++b)
#pragma unroll
                for (int m = 0; m < 4; ++m)
#pragma unroll
                    for (int n = 0; n < 2; ++n) acc[a][b][m][n] = (f32x4){0.f, 0.f, 0.f, 0.f};
        cur = nxt; cA = nA; cB = nB; ++ui;
    }
    PG8_WAIT_V(0);
    if (wr == 0) PG8_BAR;
    PG8_BAR;
    if constexpr (Epi::AFTER_DRAIN) { E.fused(acc, cur, wr, wc, fr, fq, lds, wid, lane); S.done(cur); }
    PG8_STAMP();
    if (STAMP && wid == 0) { stamps[lane] = lane < nts ? (((unsigned long long)(unsigned)ts_hi << 32) | (unsigned)ts_lo) : 0ull;
        if (lane == 62) stamps[62] = rt_entry; if (lane == 63) stamps[63] = (unsigned long long)wall_clock64(); }
#undef PG8_STAMP
#undef PG8_SA
#undef PG8_SB
#undef PG8_STAGE
#undef PG8_LDA
#undef PG8_LDB
#undef PG8_MMA
#undef PG8_WAIT_V
#undef PG8_WAIT_L
#undef PG8_BAR
#undef PG8_SCHED
}
}
using pg8::bf16_t; using pg8::bf16x8; using pg8::f32x4; using pg8::Unit;
#define LAS __attribute__((address_space(3)))

constexpr int D = 1024, NB = 4, SEQ = 8192, MLAT = NB * SEQ, CTXL = 256, MCTX = NB * CTXL, MALL = MLAT + MCTX;
constexpr int FF = 2816, NT = 512;
constexpr int LDS_BYTES = 147456;

constexpr size_t al256(size_t x) { return (x + 255) & ~(size_t)255; }
constexpr size_t SZ_WGU = (size_t)5632 * 1024 * 2, SZ_WDN = (size_t)1024 * 2816 * 2;
constexpr size_t WS_WGU = 0;
constexpr size_t WS_WDN = WS_WGU + 4 * SZ_WGU;
constexpr size_t WS_WRW = WS_WDN + 4 * SZ_WDN;
constexpr size_t WS_WG2 = WS_WRW + (size_t)3584 * 2048 * 2;
constexpr size_t WS_WO = WS_WG2 + (size_t)1024 * 256 * 2;
constexpr size_t WS_W2T = WS_WO + (size_t)1024 * 1024 * 2;
constexpr size_t WS_A2T = WS_W2T + (size_t)2 * 1024 * 64 * 2;
constexpr size_t WS_WIN = WS_A2T + (size_t)2 * 1024 * 64 * 2;
constexpr size_t WS_WOUT = WS_WIN + (size_t)3072 * 1024 * 2;
constexpr size_t WS_MOD = WS_WOUT + (size_t)1024 * 1024 * 2;
constexpr size_t WS_HID2 = WS_MOD + al256((size_t)2 * 5 * 9216 * 4);
constexpr size_t WS_TW = WS_HID2 + (size_t)64 * 8192 * 4;
constexpr size_t WS_XC = WS_TW + (size_t)8192 * 8;
constexpr size_t WS_BSUM = WS_XC + (size_t)1024 * 1024 * 4;
constexpr size_t WS_R1 = WS_BSUM + (size_t)2 * 32768 * 16 * 4;
constexpr size_t SZ_R1 = (size_t)MALL * 2048 * 2;
constexpr size_t WS_R2 = WS_R1 + SZ_R1;
constexpr size_t SZ_R2 = (size_t)MALL * 1024 * 2 * 3;
constexpr size_t WS_R3 = WS_R2 + SZ_R2;
constexpr size_t SZ_R3 = (size_t)MALL * 512 * 2;
constexpr size_t WS_END = WS_R3 + SZ_R3;

struct Params { const float* in[38]; float* out; unsigned char* ws; };
enum { I_X = 0, I_C, I_CTX, I_CCTX, I_MODW, I_MODB, I_NORMG, I_WGU, I_WDN, I_MIX, I_WRKV, I_WO, I_W0, I_W1, I_W2, I_A0, I_A1, I_A2, I_G1, I_G2,
       I_KK, I_KA, I_RK, I_LNG, I_LNB, I_HWIN, I_HCW, I_HCB, I_FW1, I_FB1, I_FFREQ, I_FW2, I_FB2, I_FW3, I_DELTAS, I_HBIAS, I_HWOUT, I_FINALG };

__device__ __forceinline__ int ltid() { int t = threadIdx.x; asm volatile("" : "+v"(t)); return t; }
__device__ __forceinline__ float bf2f(unsigned short b) { return __uint_as_float(((unsigned)b) << 16); }
__device__ __forceinline__ float bflo(unsigned u) { return __uint_as_float(u << 16); }
__device__ __forceinline__ float bfhi(unsigned u) { return __uint_as_float(u & 0xffff0000u); }
__device__ __forceinline__ unsigned pk2(float lo, float hi) { return pg8::cvt_pk_bf16(lo, hi); }
__device__ __forceinline__ float sigm(float x) { return 1.f / (1.f + __expf(-x)); }
__device__ __forceinline__ float wave_sum(float v) {
#pragma unroll
    for (int o = 32; o >= 1; o >>= 1) v += __shfl_xor(v, o, 64);
    return v;
}

template <class F> __device__ void transpose_cvt(const F f, bf16_t* dst, int N, int K, float* tile) {
    const int tid = ltid(), ntn = N >> 6, ntk = K >> 6;
    for (int t = blockIdx.x; t < ntn * ntk; t += gridDim.x) {
        const int tn = t % ntn, tk = t / ntn, n0 = tn * 64, k0 = tk * 64;
#pragma unroll
        for (int i = 0; i < 8; ++i) { const int r = (tid >> 6) + 8 * i, c = tid & 63; tile[r * 65 + c] = f(n0 + c, k0 + r); }
        __syncthreads();
#pragma unroll
        for (int i = 0; i < 4; ++i) { const int idx = tid + 512 * i, nn = idx >> 5, kp = idx & 31;
            *(unsigned*)(dst + (size_t)(n0 + nn) * K + k0 + 2 * kp) = pk2(tile[(2 * kp) * 65 + nn], tile[(2 * kp + 1) * 65 + nn]); }
        __syncthreads();
    }
}
struct FGu { const float* w; __device__ float operator()(int n, int k) const { const int pn = n >> 8, r = n & 255; const int col = (r < 128) ? (pn * 128 + r) : (FF + pn * 128 + (r - 128)); return w[(size_t)k * 5632 + col]; } };
struct FPlain { const float* w; int ld; __device__ float operator()(int n, int k) const { return w[(size_t)k * ld + n]; } };
struct FRw { const float *rkv, *w1, *a1, *g1, *mix;
    __device__ float operator()(int n, int k) const {
        const int kk = k & 1023; float v; int mi;
        if (n < 3072) { const int j = n >> 10; v = rkv[((size_t)j * 1024 + kk) * 1024 + (n & 1023)]; mi = (j == 0) ? 0 : (j == 1 ? 2 : 3); }
        else if (n < 3200) { const int q = n - 3072; v = w1[((size_t)(q >> 6) * 1024 + kk) * 64 + (q & 63)]; mi = 1; }
        else if (n < 3328) { const int q = n - 3200; v = a1[((size_t)(q >> 6) * 1024 + kk) * 64 + (q & 63)]; mi = 4; }
        else if (n < 3488) { const int q = n - 3328; v = g1[(size_t)kk * 160 + q]; mi = 5; }
        else return 0.f;
        if (k >= 1024) v *= mix[mi * 1024 + kk];
        return v; } };
struct FG2 { const float* g2; __device__ float operator()(int n, int k) const { return k < 160 ? g2[(size_t)k * 1024 + n] : 0.f; } };
struct FLora2 { const float* w2; __device__ float operator()(int n, int k) const { const int dir = n >> 10; return w2[((size_t)dir * 64 + k) * 1024 + (n & 1023)]; } };

__device__ void mod_phase(const Params& p, float* mod, float* ldsf) {
    const int tid = ltid(), lane = tid & 63, wave = tid >> 6;
    float* sc = ldsf; float* red = ldsf + 5 * 1024;
    for (int i = tid; i < 5 * 1024; i += NT) { const int m = i >> 10, k = i & 1023; const float v = m < 4 ? p.in[I_C][m * 1024 + k] : p.in[I_CCTX][k]; sc[i] = v * sigm(v); }
    __syncthreads();
    const int kq = lane >> 4, cq = lane & 15;
    for (int cb = blockIdx.x; cb < 288; cb += gridDim.x) {
        const int layer = cb / 144, col0 = (cb % 144) * 64;
        const float* W = p.in[I_MODW] + (size_t)layer * 1024 * 9216;
        float acc[5][4];
#pragma unroll
        for (int m = 0; m < 5; ++m)
#pragma unroll
            for (int e = 0; e < 4; ++e) acc[m][e] = 0.f;
#pragma unroll 8
        for (int i = 0; i < 32; ++i) { const int k = wave * 128 + 4 * i + kq; const float4 w = *(const float4*)(W + (size_t)k * 9216 + col0 + 4 * cq);
#pragma unroll
            for (int m = 0; m < 5; ++m) { const float s = sc[m * 1024 + k]; acc[m][0] += s * w.x; acc[m][1] += s * w.y; acc[m][2] += s * w.z; acc[m][3] += s * w.w; } }
#pragma unroll
        for (int m = 0; m < 5; ++m)
#pragma unroll
            for (int e = 0; e < 4; ++e) { float a = acc[m][e]; a += __shfl_xor(a, 16, 64); a += __shfl_xor(a, 32, 64); if (kq == 0) red[(wave * 5 + m) * 64 + 4 * cq + e] = a; }
        __syncthreads();
        if (tid < 320) { const int m = tid >> 6, cc = tid & 63; float s = 0.f;
#pragma unroll
            for (int w = 0; w < 8; ++w) s += red[(w * 5 + m) * 64 + cc];
            mod[((size_t)layer * 5 + m) * 9216 + col0 + cc] = s + p.in[I_MODB][layer * 9216 + col0 + cc]; }
        __syncthreads();
    }
}

__device__ void hid_phase(const Params& p, float* hid2T, float2* tw, float* ldsf) {
    const int tid = ltid(), rr = tid >> 6, j = tid & 63;
    float* zs = ldsf; float* h1 = ldsf + 8 * 36;
    const float *w1 = p.in[I_FW1], *b1 = p.in[I_FB1], *fq = p.in[I_FFREQ], *w2 = p.in[I_FW2], *b2 = p.in[I_FB2];
    for (int it = blockIdx.x; it < 1024; it += gridDim.x) {
        const int l = it * 8 + rr;
        if (j < 33) { float z;
            if (j == 0) z = (float)l / 8191.f;
            else { const int bi = (j - 1) & 15; const float band = 1e-4f + (float)bi * ((15.f - 1e-4f) / 15.f); const float ang = (7.66990393942820614859e-4f * (float)l) * band; z = (j <= 16) ? cosf(ang) : -sinf(ang); }
            zs[rr * 36 + j] = z; }
        __syncthreads();
        float a = b1[j];
        for (int i = 0; i < 33; ++i) a += zs[rr * 36 + i] * w1[i * 64 + j];
        h1[rr * 64 + j] = sinf(fq[j] * a);
        __syncthreads();
        float a2 = b2[j];
        for (int i = 0; i < 64; ++i) a2 += h1[rr * 64 + i] * w2[i * 64 + j];
        hid2T[(size_t)j * 8192 + l] = sinf(fq[64 + j] * a2);
        __syncthreads();
    }
    for (int i = blockIdx.x * NT + tid; i < 8192; i += gridDim.x * NT) { float s, c; sincospif((float)i / 8192.f, &s, &c); tw[i] = make_float2(c, -s); }
}

__device__ void prenorm_phase(const float* xl, const float* xc, const float* g, const float* mod, int ish, int isc, bf16_t* out, int out_ld, int nrows) {
    const int lane = ltid() & 63, gw = blockIdx.x * 8 + (ltid() >> 6), nw = gridDim.x * 8;
    for (int r = gw; r < nrows; r += nw) {
        const float* src = r < MLAT ? xl + (size_t)r * 1024 : xc + (size_t)(r - MLAT) * 1024;
        const int m = r < MLAT ? (r >> 13) : 4;
        const float* sh = mod + (size_t)m * 9216 + ish * 1024; const float* sc = mod + (size_t)m * 9216 + isc * 1024;
        float4 v[4]; float ss = 0.f;
#pragma unroll
        for (int i = 0; i < 4; ++i) { v[i] = *(const float4*)(src + 4 * (lane + 64 * i)); ss += v[i].x * v[i].x + v[i].y * v[i].y + v[i].z * v[i].z + v[i].w * v[i].w; }
        ss = wave_sum(ss);
        const float rstd = rsqrtf(ss * (1.f / 1024.f) + 1e-6f);
#pragma unroll
        for (int i = 0; i < 4; ++i) { const int c = 4 * (lane + 64 * i);
            const float4 g4 = *(const float4*)(g + c), s4 = *(const float4*)(sh + c), c4 = *(const float4*)(sc + c);
            const float o0 = v[i].x * rstd * g4.x * (1.f + c4.x) + s4.x, o1 = v[i].y * rstd * g4.y * (1.f + c4.y) + s4.y;
            const float o2 = v[i].z * rstd * g4.z * (1.f + c4.z) + s4.z, o3 = v[i].w * rstd * g4.w * (1.f + c4.w) + s4.w;
            uint2 o; o.x = pk2(o0, o1); o.y = pk2(o2, o3);
            *(uint2*)(out + (size_t)r * out_ld + c) = o; }
    }
}
__device__ void final_norm_phase(float* x, const float* g) {
    const int lane = ltid() & 63, gw = blockIdx.x * 8 + (ltid() >> 6), nw = gridDim.x * 8;
    for (int r = gw; r < MLAT; r += nw) {
        float* src = x + (size_t)r * 1024; float4 v[4]; float ss = 0.f;
#pragma unroll
        for (int i = 0; i < 4; ++i) { v[i] = *(const float4*)(src + 4 * (lane + 64 * i)); ss += v[i].x * v[i].x + v[i].y * v[i].y + v[i].z * v[i].z + v[i].w * v[i].w; }
        ss = wave_sum(ss);
        const float rstd = rsqrtf(ss * (1.f / 1024.f) + 1e-6f);
#pragma unroll
        for (int i = 0; i < 4; ++i) { const int c = 4 * (lane + 64 * i); const float4 g4 = *(const float4*)(g + c);
            float4 o; o.x = v[i].x * rstd * g4.x; o.y = v[i].y * rstd * g4.y; o.z = v[i].z * rstd * g4.z; o.w = v[i].w * rstd * g4.w;
            *(float4*)(src + c) = o; }
    }
}

struct EpiSwiglu {
    static constexpr bool PERM = true, AFTER_DRAIN = false;
    bf16_t* H;
    __device__ __forceinline__ void operator()(const f32x4 (&acc)[2][2][4][2], const Unit& u, int wr, int wc, int fr, int fq) const {
        const int row0 = u.pm * 256 + wr * 64 + fr, col0 = u.pn * 128 + wc * 32 + 8 * fq;
#pragma unroll
        for (int ai = 0; ai < 2; ++ai)
#pragma unroll
            for (int m = 0; m < 4; ++m) { const f32x4 g0 = acc[ai][0][m][0], g1 = acc[ai][0][m][1], u0 = acc[ai][1][m][0], u1 = acc[ai][1][m][1];
                float h[8];
#pragma unroll
                for (int e = 0; e < 4; ++e) { h[e] = g0[e] * sigm(g0[e]) * u0[e]; h[4 + e] = g1[e] * sigm(g1[e]) * u1[e]; }
                uint4 o; o.x = pk2(h[0], h[1]); o.y = pk2(h[2], h[3]); o.z = pk2(h[4], h[5]); o.w = pk2(h[6], h[7]);
                *(uint4*)(H + (size_t)(row0 + ai * 128 + m * 16) * FF + col0) = o; }
    }
};
struct EpiResid {
    static constexpr bool PERM = false, AFTER_DRAIN = false;
    const float* src_l; float* dst_l; const float* src_c; float* dst_c; const float* mod; int ig; float coef;
    __device__ __forceinline__ void operator()(const f32x4 (&acc)[2][2][4][2], const Unit& u, int wr, int wc, int fr, int fq) const {
        const bool lat = u.pm < 128; const float* src = lat ? src_l : src_c; float* dst = lat ? dst_l : dst_c;
        const int rbase = (lat ? u.pm : u.pm - 128) * 256 + wr * 64 + fr, mi = lat ? (u.pm >> 5) : 4, col0 = u.pn * 256 + wc * 32 + 4 * fq;
        const float* gp = mod + (size_t)mi * 9216 + ig * 1024 + col0;
        f32x4 gv[2][2];
#pragma unroll
        for (int bj = 0; bj < 2; ++bj)
#pragma unroll
            for (int n = 0; n < 2; ++n) gv[bj][n] = *(const f32x4*)(gp + bj * 128 + n * 16) * coef;
#pragma unroll
        for (int ai = 0; ai < 2; ++ai)
#pragma unroll
            for (int m = 0; m < 4; ++m) { const size_t ro = (size_t)(rbase + ai * 128 + m * 16) * 1024 + col0;
#pragma unroll
                for (int bj = 0; bj < 2; ++bj)
#pragma unroll
                    for (int n = 0; n < 2; ++n) { const size_t off = ro + bj * 128 + n * 16; const f32x4 s = *(const f32x4*)(src + off); *(f32x4*)(dst + off) = s + gv[bj][n] * acc[ai][bj][m][n]; } }
    }
};
template <class Epi> __device__ __forceinline__ void run_gemm(LAS unsigned char* lds, const bf16_t* A, const bf16_t* Bt, int M, int N, int K, const Epi& E) {
    pg8::Gemm g{A, Bt, M, N, K}; pg8::StaticOrder S; S.init(M, N, (int)gridDim.x, (int)blockIdx.x);
    pg8::gemm_phase<Epi, pg8::StaticOrder, false>(lds, g, S, E, nullptr);
}
__device__ void dshift_phase(bf16_t* A2) {
    const int lane = ltid() & 63, gw = blockIdx.x * 8 + (ltid() >> 6), nw = gridDim.x * 8;
    for (int r = gw; r < MALL; r += nw) {
#pragma unroll
        for (int i = 0; i < 2; ++i) { const int c = 8 * (lane + 64 * i), q = c >> 8; int nb = -1;
            if (r < MLAT) { const int t = r & 8191, gy = t >> 6, gx = t & 63;
                if (q == 0) nb = gx > 0 ? r - 1 : -1; else if (q == 1) nb = gx < 63 ? r + 1 : -1; else if (q == 2) nb = gy > 0 ? r - 64 : -1; else nb = gy < 127 ? r + 64 : -1; }
            else { const int t = (r - MLAT) & 255; nb = ((q & 1) == 0) ? (t > 0 ? r - 1 : -1) : (t < 255 ? r + 1 : -1); }
            const uint4 hv = *(const uint4*)(A2 + (size_t)r * 2048 + c);
            uint4 nv = make_uint4(0u, 0u, 0u, 0u);
            if (nb >= 0) nv = *(const uint4*)(A2 + (size_t)nb * 2048 + c);
            uint4 o;
            o.x = pk2(bflo(nv.x) - bflo(hv.x), bfhi(nv.x) - bfhi(hv.x)); o.y = pk2(bflo(nv.y) - bflo(hv.y), bfhi(nv.y) - bfhi(hv.y));
            o.z = pk2(bflo(nv.z) - bflo(hv.z), bfhi(nv.z) - bfhi(hv.z)); o.w = pk2(bflo(nv.w) - bflo(hv.w), bfhi(nv.w) - bfhi(hv.w));
            *(uint4*)(A2 + (size_t)r * 2048 + 1024 + c) = o; }
    }
}
__device__ __forceinline__ uint4 pack8(const f32x4 a, const f32x4 b) { uint4 o; o.x = pk2(a[0], a[1]); o.y = pk2(a[2], a[3]); o.z = pk2(b[0], b[1]); o.w = pk2(b[2], b[3]); return o; }
__device__ __forceinline__ float tanh_(float x) { return 1.f - 2.f / (1.f + __expf(2.f * x)); }
struct EpiRwkv {
    static constexpr bool PERM = true, AFTER_DRAIN = false;
    bf16_t *rkv, *l1;
    __device__ __forceinline__ void operator()(const f32x4 (&acc)[2][2][4][2], const Unit& u, int wr, int wc, int fr, int fq) const {
        const int row0 = u.pm * 256 + wr * 64 + fr, cw = wc * 32 + 8 * fq;
        bf16_t* const l1w = l1; bf16_t* const l1a = l1 + (size_t)MALL * 128; bf16_t* const l1g = l1 + (size_t)MALL * 256;
        const int mode = u.pn < 12 ? 0 : (u.pn == 12 ? 1 : 2);
        bf16_t* base0; bf16_t* base1; int ld;
        if (mode == 0) { base0 = rkv + (size_t)(u.pn >> 2) * ((size_t)MALL * 1024) + (u.pn & 3) * 256 + cw; base1 = base0 + 128; ld = 1024; }
        else if (mode == 1) { base0 = l1w + cw; base1 = l1a + cw; ld = 128; }
        else { base0 = l1g + cw; base1 = l1g + 128 + cw; ld = 256; }
#pragma unroll
        for (int ai = 0; ai < 2; ++ai)
#pragma unroll
            for (int m = 0; m < 4; ++m) { const size_t ro = (size_t)(row0 + ai * 128 + m * 16) * ld;
#pragma unroll
                for (int bj = 0; bj < 2; ++bj) { f32x4 t0 = acc[ai][bj][m][0], t1 = acc[ai][bj][m][1];
                    if (mode == 1 && bj == 0) {
#pragma unroll
                        for (int e = 0; e < 4; ++e) { t0[e] = tanh_(t0[e]); t1[e] = tanh_(t1[e]); } }
                    if (mode == 2) { const bool live = (bj * 128 + cw) < 160;
#pragma unroll
                        for (int e = 0; e < 4; ++e) { t0[e] = live ? sigm(t0[e]) : 0.f; t1[e] = live ? sigm(t1[e]) : 0.f; } }
                    *(uint4*)((bj ? base1 : base0) + ro) = pack8(t0, t1); } }
    }
};
struct EpiG {
    static constexpr bool PERM = true, AFTER_DRAIN = false;
    const bf16_t* yn; bf16_t* ao;
    __device__ __forceinline__ void operator()(const f32x4 (&acc)[2][2][4][2], const Unit& u, int wr, int wc, int fr, int fq) const {
        const int row0 = u.pm * 256 + wr * 64 + fr, col0 = u.pn * 256 + wc * 32 + 8 * fq;
#pragma unroll
        for (int ai = 0; ai < 2; ++ai)
#pragma unroll
            for (int m = 0; m < 4; ++m)
#pragma unroll
                for (int bj = 0; bj < 2; ++bj) { const size_t off = (size_t)(row0 + ai * 128 + m * 16) * 1024 + col0 + bj * 128;
                    const uint4 y = *(const uint4*)(yn + off); const f32x4 a0 = acc[ai][bj][m][0], a1 = acc[ai][bj][m][1];
                    uint4 o; o.x = pk2(bflo(y.x) * a0[0], bfhi(y.x) * a0[1]); o.y = pk2(bflo(y.y) * a0[2], bfhi(y.y) * a0[3]);
                    o.z = pk2(bflo(y.z) * a1[0], bfhi(y.z) * a1[1]); o.w = pk2(bflo(y.w) * a1[2], bfhi(y.w) * a1[3]);
                    *(uint4*)(ao + off) = o; asm volatile("" ::: "memory"); }
    }
};
struct EpiBf16Plain {
    static constexpr bool PERM = true, AFTER_DRAIN = false;
    bf16_t* O; int ld;
    __device__ __forceinline__ void operator()(const f32x4 (&acc)[2][2][4][2], const Unit& u, int wr, int wc, int fr, int fq) const {
        const int row0 = u.pm * 256 + wr * 64 + fr, col0 = u.pn * 256 + wc * 32 + 8 * fq;
#pragma unroll
        for (int ai = 0; ai < 2; ++ai)
#pragma unroll
            for (int m = 0; m < 4; ++m)
#pragma unroll
                for (int bj = 0; bj < 2; ++bj) *(uint4*)(O + (size_t)(row0 + ai * 128 + m * 16) * ld + col0 + bj * 128) = pack8(acc[ai][bj][m][0], acc[ai][bj][m][1]);
    }
};

template <int N> __device__ __forceinline__ float dpp_ror(float x) { return __int_as_float(__builtin_amdgcn_update_dpp(0, __float_as_int(x), 0x120 + N, 0xf, 0xf, false)); }
__device__ __forceinline__ float row_allsum16(float x) { x += dpp_ror<8>(x); x += dpp_ror<4>(x); x += dpp_ror<2>(x); x += dpp_ror<1>(x); return x; }
__device__ __forceinline__ int scan_tokrow(int ci, int slot, int dir, int b) {
    if (ci < 4) { const int s = ci * 64 + slot; return MLAT + b * 256 + (dir ? 255 - s : s); }
    const int s = (ci - 4) * 64 + slot; return b * 8192 + (dir ? 8191 - s : s);
}
__device__ void scan_phase(const Params& p, unsigned char* ws, float* ldsf) {
    const int tid = ltid(), lane = tid & 63, wave = tid >> 6;
    const bf16_t* Rb = (const bf16_t*)(ws + WS_R2); const bf16_t* Kb = Rb + (size_t)MALL * 1024; const bf16_t* Vb = Kb + (size_t)MALL * 1024;
    const bf16_t* L1w = (const bf16_t*)(ws + WS_R3); const bf16_t* L1a = L1w + (size_t)MALL * 128;
    bf16_t* Yd = (bf16_t*)(ws + WS_R1);
    float* bsum = (float*)(ws + WS_BSUM);
    const bf16_t* w2t = (const bf16_t*)(ws + WS_W2T); const bf16_t* a2t = (const bf16_t*)(ws + WS_A2T);
    float* Wl = ldsf; float* KDl = ldsf + 4096; float* KKl = ldsf + 8192; float* KAl = ldsf + 12288; float* Rl = ldsf + 16384; float* Vl = ldsf + 20480; float* Yl = ldsf + 24576;
    for (int wi = blockIdx.x; wi < 256; wi += gridDim.x) {
        const int chain = wi >> 1, half = wi & 1, dir = chain >> 6, b = (chain >> 4) & 3, h = chain & 15;
        const int rr = tid >> 4, ks = tid & 15, slot2 = tid >> 3, cg8 = tid & 7, ch0 = h * 64 + 8 * cg8;
        const int mt = wave & 3, nh = wave >> 2, l15 = lane & 15, lq = lane >> 4;
        float S0 = 0.f, S1 = 0.f, S2 = 0.f, S3 = 0.f;
        float kkc[8], kac[8], rkc[8];
#pragma unroll
        for (int e = 0; e < 8; ++e) { kkc[e] = p.in[I_KK][ch0 + e]; kac[e] = p.in[I_KA][ch0 + e]; rkc[e] = p.in[I_RK][ch0 + e]; }
        bf16x8 bw[2][2], ba[2][2]; float w0v[2], a0v[2];
#pragma unroll
        for (int nt = 0; nt < 2; ++nt) { const int n = h * 64 + 32 * nh + 16 * nt + l15;
            w0v[nt] = p.in[I_W0][dir * 1024 + n]; a0v[nt] = p.in[I_A0][dir * 1024 + n];
#pragma unroll
            for (int k2 = 0; k2 < 2; ++k2) { bw[nt][k2] = *(const bf16x8*)(w2t + (size_t)(dir * 1024 + n) * 64 + k2 * 32 + lq * 8); ba[nt][k2] = *(const bf16x8*)(a2t + (size_t)(dir * 1024 + n) * 64 + k2 * 32 + lq * 8); } }
        bf16x8 paw[2], paa[2]; uint4 pk_, pv_, pr_;
#define SCAN_LOAD(ci) do { const int _ra = scan_tokrow((ci), 16 * mt + l15, dir, b); \
            paw[0] = *(const bf16x8*)(L1w + (size_t)_ra * 128 + dir * 64 + lq * 8); paw[1] = *(const bf16x8*)(L1w + (size_t)_ra * 128 + dir * 64 + 32 + lq * 8); \
            paa[0] = *(const bf16x8*)(L1a + (size_t)_ra * 128 + dir * 64 + lq * 8); paa[1] = *(const bf16x8*)(L1a + (size_t)_ra * 128 + dir * 64 + 32 + lq * 8); \
            const int _rb = scan_tokrow((ci), slot2, dir, b); \
            pk_ = *(const uint4*)(Kb + (size_t)_rb * 1024 + ch0); pv_ = *(const uint4*)(Vb + (size_t)_rb * 1024 + ch0); pr_ = *(const uint4*)(Rb + (size_t)_rb * 1024 + ch0); } while (0)
        SCAN_LOAD(0);
        for (int ci = 0; ci < 132; ++ci) {
            {
                f32x4 cw[2], ca[2];
#pragma unroll
                for (int nt = 0; nt < 2; ++nt) { const f32x4 z = {0.f, 0.f, 0.f, 0.f};
                    cw[nt] = __builtin_amdgcn_mfma_f32_16x16x32_bf16(paw[0], bw[nt][0], z, 0, 0, 0); cw[nt] = __builtin_amdgcn_mfma_f32_16x16x32_bf16(paw[1], bw[nt][1], cw[nt], 0, 0, 0);
                    ca[nt] = __builtin_amdgcn_mfma_f32_16x16x32_bf16(paa[0], ba[nt][0], z, 0, 0, 0); ca[nt] = __builtin_amdgcn_mfma_f32_16x16x32_bf16(paa[1], ba[nt][1], ca[nt], 0, 0, 0); }
#pragma unroll
                for (int nt = 0; nt < 2; ++nt)
#pragma unroll
                    for (int j = 0; j < 4; ++j) { const int slot = 16 * mt + 4 * lq + j, chl = 32 * nh + 16 * nt + l15;
                        Wl[slot * 64 + chl] = __expf(-0.60653065971263342f * sigm(w0v[nt] + cw[nt][j]));
                        KAl[slot * 64 + chl] = sigm(a0v[nt] + ca[nt][j]); }
            }
            __syncthreads();
            {
                float k8[8], v8[8], r8[8];
                k8[0] = bflo(pk_.x); k8[1] = bfhi(pk_.x); k8[2] = bflo(pk_.y); k8[3] = bfhi(pk_.y); k8[4] = bflo(pk_.z); k8[5] = bfhi(pk_.z); k8[6] = bflo(pk_.w); k8[7] = bfhi(pk_.w);
                v8[0] = bflo(pv_.x); v8[1] = bfhi(pv_.x); v8[2] = bflo(pv_.y); v8[3] = bfhi(pv_.y); v8[4] = bflo(pv_.z); v8[5] = bfhi(pv_.z); v8[6] = bflo(pv_.w); v8[7] = bfhi(pv_.w);
                r8[0] = bflo(pr_.x); r8[1] = bfhi(pr_.x); r8[2] = bflo(pr_.y); r8[3] = bfhi(pr_.y); r8[4] = bflo(pr_.z); r8[5] = bfhi(pr_.z); r8[6] = bflo(pr_.w); r8[7] = bfhi(pr_.w);
                float kkr[8], ss = 0.f;
#pragma unroll
                for (int e = 0; e < 8; ++e) { kkr[e] = k8[e] * kkc[e]; ss += kkr[e] * kkr[e]; }
                ss += __shfl_xor(ss, 1, 64); ss += __shfl_xor(ss, 2, 64); ss += __shfl_xor(ss, 4, 64);
                const float rn = 1.f / fmaxf(sqrtf(ss), 1e-12f);
                const float4 a_lo = *(const float4*)(KAl + slot2 * 64 + 8 * cg8), a_hi = *(const float4*)(KAl + slot2 * 64 + 8 * cg8 + 4);
                const float av[8] = {a_lo.x, a_lo.y, a_lo.z, a_lo.w, a_hi.x, a_hi.y, a_hi.z, a_hi.w};
                float kd[8], kk[8], ka[8], bp = 0.f;
#pragma unroll
                for (int e = 0; e < 8; ++e) { kd[e] = k8[e] * (1.f + (av[e] - 1.f) * kac[e]); kk[e] = kkr[e] * rn; ka[e] = kk[e] * av[e]; bp += r8[e] * kd[e] * rkc[e]; }
                bp += __shfl_xor(bp, 1, 64); bp += __shfl_xor(bp, 2, 64); bp += __shfl_xor(bp, 4, 64);
                const int o = slot2 * 64 + 8 * cg8;
                *(float4*)(KDl + o) = make_float4(kd[0], kd[1], kd[2], kd[3]); *(float4*)(KDl + o + 4) = make_float4(kd[4], kd[5], kd[6], kd[7]);
                *(float4*)(KKl + o) = make_float4(kk[0], kk[1], kk[2], kk[3]); *(float4*)(KKl + o + 4) = make_float4(kk[4], kk[5], kk[6], kk[7]);
                *(float4*)(KAl + o) = make_float4(ka[0], ka[1], ka[2], ka[3]); *(float4*)(KAl + o + 4) = make_float4(ka[4], ka[5], ka[6], ka[7]);
                *(float4*)(Rl + o) = make_float4(r8[0], r8[1], r8[2], r8[3]); *(float4*)(Rl + o + 4) = make_float4(r8[4], r8[5], r8[6], r8[7]);
                *(float4*)(Vl + o) = make_float4(v8[0], v8[1], v8[2], v8[3]); *(float4*)(Vl + o + 4) = make_float4(v8[4], v8[5], v8[6], v8[7]);
                if (ci >= 4 && half == 0 && cg8 == 0) bsum[((size_t)dir * MLAT + scan_tokrow(ci, slot2, dir, b)) * 16 + h] = bp;
            }
            __syncthreads();
            if (ci + 1 < 132) SCAN_LOAD(ci + 1);
#pragma unroll 2
            for (int s = 0; s < 64; ++s) {
                const float4 kk4 = *(const float4*)(KKl + s * 64 + 4 * ks), w4 = *(const float4*)(Wl + s * 64 + 4 * ks), ka4 = *(const float4*)(KAl + s * 64 + 4 * ks);
                const float4 kd4 = *(const float4*)(KDl + s * 64 + 4 * ks), r4 = *(const float4*)(Rl + s * 64 + 4 * ks);
                const float vv = Vl[s * 64 + half * 32 + rr];
                float sa = S0 * kk4.x + S1 * kk4.y + S2 * kk4.z + S3 * kk4.w;
                sa = row_allsum16(sa);
                S0 = S0 * w4.x + (vv * kd4.x - sa * ka4.x); S1 = S1 * w4.y + (vv * kd4.y - sa * ka4.y);
                S2 = S2 * w4.z + (vv * kd4.z - sa * ka4.z); S3 = S3 * w4.w + (vv * kd4.w - sa * ka4.w);
                float y = S0 * r4.x + S1 * r4.y + S2 * r4.z + S3 * r4.w;
                y = row_allsum16(y);
                if (ks == 0) Yl[s * 32 + rr] = y;
            }
            __syncthreads();
            if (ci >= 4) { const float4 y4 = *(const float4*)(Yl + slot2 * 32 + 4 * cg8); const int row = scan_tokrow(ci, slot2, dir, b);
                uint2 o; o.x = pk2(y4.x, y4.y); o.y = pk2(y4.z, y4.w);
                *(uint2*)(Yd + ((size_t)dir * MLAT + row) * 1024 + h * 64 + half * 32 + 4 * cg8) = o; }
        }
#undef SCAN_LOAD
        __syncthreads();
    }
}
__device__ void post_phase(const Params& p, unsigned char* ws) {
    const int lane = ltid() & 63, gw = blockIdx.x * 8 + (ltid() >> 6), nw = gridDim.x * 8;
    const bf16_t* Yd = (const bf16_t*)(ws + WS_R1); const bf16_t* Vb = (const bf16_t*)(ws + WS_R2) + (size_t)2 * MALL * 1024;
    bf16_t* YN = (bf16_t*)(ws + WS_R2); const float* bsum = (const float*)(ws + WS_BSUM);
    const int c0 = 16 * lane, head = lane >> 2;
    float lg[16], lb[16];
#pragma unroll
    for (int e = 0; e < 16; ++e) { lg[e] = p.in[I_LNG][c0 + e]; lb[e] = p.in[I_LNB][c0 + e]; }
    for (int r = gw; r < MLAT; r += nw) {
        const uint4 f0 = *(const uint4*)(Yd + (size_t)r * 1024 + c0), f1 = *(const uint4*)(Yd + (size_t)r * 1024 + c0 + 8);
        const uint4 b0 = *(const uint4*)(Yd + ((size_t)MLAT + r) * 1024 + c0), b1 = *(const uint4*)(Yd + ((size_t)MLAT + r) * 1024 + c0 + 8);
        const uint4 v0 = *(const uint4*)(Vb + (size_t)r * 1024 + c0), v1 = *(const uint4*)(Vb + (size_t)r * 1024 + c0 + 8);
        const unsigned fu[8] = {f0.x, f0.y, f0.z, f0.w, f1.x, f1.y, f1.z, f1.w}, bu[8] = {b0.x, b0.y, b0.z, b0.w, b1.x, b1.y, b1.z, b1.w}, vu[8] = {v0.x, v0.y, v0.z, v0.w, v1.x, v1.y, v1.z, v1.w};
        float y[16], s = 0.f;
#pragma unroll
        for (int e = 0; e < 8; ++e) { y[2 * e] = bflo(fu[e]) + bflo(bu[e]); y[2 * e + 1] = bfhi(fu[e]) + bfhi(bu[e]); s += y[2 * e] + y[2 * e + 1]; }
        s += __shfl_xor(s, 1, 64); s += __shfl_xor(s, 2, 64);
        const float mu = s * (1.f / 64.f); float q = 0.f;
#pragma unroll
        for (int e = 0; e < 16; ++e) { const float d = y[e] - mu; q += d * d; }
        q += __shfl_xor(q, 1, 64); q += __shfl_xor(q, 2, 64);
        const float rs = rsqrtf(q * (1.f / 64.f) + 64e-5f);
        const float bs = 0.5f * (bsum[(size_t)r * 16 + head] + bsum[((size_t)MLAT + r) * 16 + head]);
        unsigned ou[8];
#pragma unroll
        for (int e = 0; e < 8; ++e) { const float o0 = (y[2 * e] - mu) * rs * lg[2 * e] + lb[2 * e] + bs * bflo(vu[e]), o1 = (y[2 * e + 1] - mu) * rs * lg[2 * e + 1] + lb[2 * e + 1] + bs * bfhi(vu[e]); ou[e] = pk2(o0, o1); }
        *(uint4*)(YN + (size_t)r * 1024 + c0) = make_uint4(ou[0], ou[1], ou[2], ou[3]); *(uint4*)(YN + (size_t)r * 1024 + c0 + 8) = make_uint4(ou[4], ou[5], ou[6], ou[7]);
    }
}

__device__ __forceinline__ float2 cmul(float2 a, float2 b) { return make_float2(a.x * b.x - a.y * b.y, a.x * b.y + a.y * b.x); }
__device__ __forceinline__ float2 cadd(float2 a, float2 b) { return make_float2(a.x + b.x, a.y + b.y); }
__device__ __forceinline__ float2 csub(float2 a, float2 b) { return make_float2(a.x - b.x, a.y - b.y); }
__device__ void fft_fwd(float2* X, const float2* tw) {
    const int tid = ltid();
#pragma unroll 1
    for (int s = 0; s < 14; s += 2) {
        const int hq = 16384 >> (s + 2);
#pragma unroll 2
        for (int q = 0; q < 8; ++q) { const int j = tid + 512 * q, g = j >> (12 - s), pos = j & (hq - 1), p0 = (g << (14 - s)) + pos;
            const float2 a0 = X[p0], a1 = X[p0 + hq], a2 = X[p0 + 2 * hq], a3 = X[p0 + 3 * hq];
            const float2 T0 = tw[pos << s], U = tw[pos << (s + 1)], T1 = make_float2(T0.y, -T0.x);
            const float2 b0 = cadd(a0, a2), b2 = cmul(csub(a0, a2), T0), b1 = cadd(a1, a3), b3 = cmul(csub(a1, a3), T1);
            X[p0] = cadd(b0, b1); X[p0 + hq] = cmul(csub(b0, b1), U); X[p0 + 2 * hq] = cadd(b2, b3); X[p0 + 3 * hq] = cmul(csub(b2, b3), U); }
        __syncthreads();
    }
}
__device__ void fft_inv(float2* X, const float2* tw) {
    const int tid = ltid();
#pragma unroll 1
    for (int s = 12; s >= 0; s -= 2) {
        const int hq = 16384 >> (s + 2);
#pragma unroll 2
        for (int q = 0; q < 8; ++q) { const int j = tid + 512 * q, g = j >> (12 - s), pos = j & (hq - 1), p0 = (g << (14 - s)) + pos;
            const float2 c0 = X[p0], c1 = X[p0 + hq], c2 = X[p0 + 2 * hq], c3 = X[p0 + 3 * hq];
            const float2 T0 = tw[pos << s], U = tw[pos << (s + 1)];
            const float2 Uc = make_float2(U.x, -U.y), T0c = make_float2(T0.x, -T0.y), T1c = make_float2(T0.y, T0.x);
            float2 t = cmul(c1, Uc); const float2 b0 = cadd(c0, t), b1 = csub(c0, t);
            t = cmul(c3, Uc); const float2 b2 = cadd(c2, t), b3 = csub(c2, t);
            t = cmul(b2, T0c); X[p0] = cadd(b0, t); X[p0 + 2 * hq] = csub(b0, t);
            t = cmul(b3, T1c); X[p0 + hq] = cadd(b1, t); X[p0 + 3 * hq] = csub(b1, t); }
        __syncthreads();
    }
}
__device__ __forceinline__ float conv3_at(const bf16_t* rowp, int t, float w0, float w1, float w2, float bias) {
    const float pm = t > 0 ? bf2f(rowp[t - 1]) : 0.f, pc = bf2f(rowp[t]), pp = t < 8191 ? bf2f(rowp[t + 1]) : 0.f;
    return pm * w0 + pc * w1 + pp * w2 + bias;
}
__device__ void fftconv_phase(const Params& p, unsigned char* ws, float2* X) {
    const int tid = ltid();
    const bf16_t* PT = (const bf16_t*)(ws + WS_R2); bf16_t* ZT = (bf16_t*)(ws + WS_R1);
    float2* Hs = (float2*)(ws + WS_R1 + (size_t)MALL * 2048) + (size_t)blockIdx.x * 32768;
    float2* zst = Hs + 16384;
    const float* hid2T = (const float*)(ws + WS_HID2); const float2* tw = (const float2*)(ws + WS_TW);
    const float *w3 = p.in[I_FW3], *cwp = p.in[I_HCW], *cbp = p.in[I_HCB];
    for (int c = blockIdx.x; c < 1024; c += gridDim.x) {
        __syncthreads();
        float4 f0[4], f1[4];
#pragma unroll
        for (int i = 0; i < 4; ++i) { f0[i] = make_float4(0.f, 0.f, 0.f, 0.f); f1[i] = make_float4(0.f, 0.f, 0.f, 0.f); }
#pragma unroll 2
        for (int j = 0; j < 64; ++j) { const float wa = w3[j * 2048 + c], wb = w3[j * 2048 + 1024 + c];
#pragma unroll
            for (int i = 0; i < 4; ++i) { const float4 hv = *(const float4*)(hid2T + (size_t)j * 8192 + 4 * (tid + 512 * i));
                f0[i].x += hv.x * wa; f0[i].y += hv.y * wa; f0[i].z += hv.z * wa; f0[i].w += hv.w * wa;
                f1[i].x += hv.x * wb; f1[i].y += hv.y * wb; f1[i].z += hv.z * wb; f1[i].w += hv.w * wb; } }
        const float d0 = fabsf(p.in[I_DELTAS][c]), d1 = fabsf(p.in[I_DELTAS][1024 + c]);
        const float bias0 = p.in[I_HBIAS][c], bias1 = p.in[I_HBIAS][1024 + c];
#pragma unroll
        for (int i = 0; i < 4; ++i) { const int l = 4 * (tid + 512 * i); const float t0 = (float)l * (1.f / 8191.f), t1 = (float)(l + 1) * (1.f / 8191.f), t2 = (float)(l + 2) * (1.f / 8191.f), t3 = (float)(l + 3) * (1.f / 8191.f);
            f0[i].x *= __expf(-t0 * d0); f0[i].y *= __expf(-t1 * d0); f0[i].z *= __expf(-t2 * d0); f0[i].w *= __expf(-t3 * d0);
            f1[i].x *= __expf(-t0 * d1); f1[i].y *= __expf(-t1 * d1); f1[i].z *= __expf(-t2 * d1); f1[i].w *= __expf(-t3 * d1); }
        const float x1w0 = cwp[c], x1w1 = cwp[3072 + c], x1w2 = cwp[6144 + c], x1b = cbp[c];
        const float x2w0 = cwp[1024 + c], x2w1 = cwp[3072 + 1024 + c], x2w2 = cwp[6144 + 1024 + c], x2b = cbp[1024 + c];
        const float vw0 = cwp[2048 + c], vw1 = cwp[3072 + 2048 + c], vw2 = cwp[6144 + 2048 + c], vb = cbp[2048 + c];
#pragma unroll
        for (int i = 0; i < 4; ++i) { const int l = 4 * (tid + 512 * i); X[l] = make_float2(f0[i].x, 0.f); X[l + 1] = make_float2(f0[i].y, 0.f); X[l + 2] = make_float2(f0[i].z, 0.f); X[l + 3] = make_float2(f0[i].w, 0.f); }
#pragma unroll
        for (int q = 0; q < 16; ++q) X[8192 + tid + 512 * q] = make_float2(0.f, 0.f);
        __syncthreads();
        fft_fwd(X, tw);
#pragma unroll 4
        for (int q = 0; q < 32; ++q) Hs[tid + 512 * q] = X[tid + 512 * q];
#pragma unroll 1
        for (int pr = 0; pr < 2; ++pr) {
            const bf16_t* v0p = PT + (size_t)(2048 + c) * 32768 + (size_t)(2 * pr) * 8192; const bf16_t* v1p = v0p + 8192;
            const bf16_t* a0p = PT + (size_t)c * 32768 + (size_t)(2 * pr) * 8192; const bf16_t* a1p = a0p + 8192;
            __syncthreads();
#pragma unroll 2
            for (int q = 0; q < 16; ++q) { const int t = tid + 512 * q; X[t] = make_float2(conv3_at(v0p, t, vw0, vw1, vw2, vb), conv3_at(v1p, t, vw0, vw1, vw2, vb)); X[8192 + t] = make_float2(0.f, 0.f); }
            __syncthreads();
            fft_fwd(X, tw);
#pragma unroll 4
            for (int q = 0; q < 32; ++q) { const int i = tid + 512 * q; X[i] = cmul(X[i], Hs[i]); }
            __syncthreads();
            fft_inv(X, tw);
#pragma unroll 2
            for (int q = 0; q < 16; ++q) { const int t = tid + 512 * q; const float2 cv = X[t];
                const float v0 = conv3_at(v0p, t, vw0, vw1, vw2, vb), v1 = conv3_at(v1p, t, vw0, vw1, vw2, vb);
                const float g0 = conv3_at(a0p, t, x1w0, x1w1, x1w2, x1b), g1 = conv3_at(a1p, t, x1w0, x1w1, x1w2, x1b);
                zst[pr * 8192 + t] = make_float2(g0 * (cv.x * (1.f / 16384.f) + v0 * bias0), g1 * (cv.y * (1.f / 16384.f) + v1 * bias0)); }
        }
        __syncthreads();
#pragma unroll
        for (int i = 0; i < 4; ++i) { const int l = 4 * (tid + 512 * i); X[l] = make_float2(f1[i].x, 0.f); X[l + 1] = make_float2(f1[i].y, 0.f); X[l + 2] = make_float2(f1[i].z, 0.f); X[l + 3] = make_float2(f1[i].w, 0.f); }
#pragma unroll
        for (int q = 0; q < 16; ++q) X[8192 + tid + 512 * q] = make_float2(0.f, 0.f);
        __syncthreads();
        fft_fwd(X, tw);
#pragma unroll 4
        for (int q = 0; q < 32; ++q) Hs[tid + 512 * q] = X[tid + 512 * q];
#pragma unroll 1
        for (int pr = 0; pr < 2; ++pr) {
            const bf16_t* b0p = PT + (size_t)(1024 + c) * 32768 + (size_t)(2 * pr) * 8192; const bf16_t* b1p = b0p + 8192;
            __syncthreads();
#pragma unroll 4
            for (int q = 0; q < 16; ++q) { const int t = tid + 512 * q; X[t] = zst[pr * 8192 + t]; X[8192 + t] = make_float2(0.f, 0.f); }
            __syncthreads();
            fft_fwd(X, tw);
#pragma unroll 4
            for (int q = 0; q < 32; ++q) { const int i = tid + 512 * q; X[i] = cmul(X[i], Hs[i]); }
            __syncthreads();
            fft_inv(X, tw);
#pragma unroll 2
            for (int q = 0; q < 16; ++q) { const int t = tid + 512 * q; const float2 cv = X[t], z = zst[pr * 8192 + t];
                const float g0 = conv3_at(b0p, t, x2w0, x2w1, x2w2, x2b), g1 = conv3_at(b1p, t, x2w0, x2w1, x2w2, x2b);
                const float o0 = g0 * (cv.x * (1.f / 16384.f) + z.x * bias1), o1 = g1 * (cv.y * (1.f / 16384.f) + z.y * bias1);
                ZT[(size_t)c * 32768 + (size_t)(2 * pr) * 8192 + t] = (bf16_t)(pk2(o0, 0.f) & 0xffffu);
                ZT[(size_t)c * 32768 + (size_t)(2 * pr + 1) * 8192 + t] = (bf16_t)(pk2(o1, 0.f) & 0xffffu); }
        }
    }
}
__device__ void transpose_phase(const bf16_t* ZT, bf16_t* Z, unsigned short* tile) {
    const int tid = ltid();
    for (int t = blockIdx.x; t < 8192; t += gridDim.x) {
        const int c0 = (t & 15) * 64, t0 = (t >> 4) * 64;
#pragma unroll
        for (int i = 0; i < 4; ++i) { const int idx = tid + 512 * i, r = idx >> 5, pp = idx & 31; const unsigned v = *(const unsigned*)(ZT + (size_t)(c0 + r) * 32768 + t0 + 2 * pp);
            tile[r * 66 + 2 * pp] = (unsigned short)(v & 0xffffu); tile[r * 66 + 2 * pp + 1] = (unsigned short)(v >> 16); }
        __syncthreads();
#pragma unroll
        for (int i = 0; i < 4; ++i) { const int idx = tid + 512 * i, tr = idx >> 5, cp = idx & 31;
            *(unsigned*)(Z + (size_t)(t0 + tr) * 1024 + c0 + 2 * cp) = (unsigned)tile[(2 * cp) * 66 + tr] | ((unsigned)tile[(2 * cp + 1) * 66 + tr] << 16); }
        __syncthreads();
    }
}
__device__ void prep_phase(const Params& p, unsigned char* ws, float* ldsf) {
    for (int f = 0; f < 4; ++f) {
        transpose_cvt(FGu{p.in[I_WGU] + (size_t)f * 1024 * 5632}, (bf16_t*)(ws + WS_WGU + f * SZ_WGU), 5632, 1024, ldsf);
        transpose_cvt(FPlain{p.in[I_WDN] + (size_t)f * 2816 * 1024, 1024}, (bf16_t*)(ws + WS_WDN + f * SZ_WDN), 1024, 2816, ldsf);
    }
    transpose_cvt(FRw{p.in[I_WRKV], p.in[I_W1], p.in[I_A1], p.in[I_G1], p.in[I_MIX]}, (bf16_t*)(ws + WS_WRW), 3584, 2048, ldsf);
    transpose_cvt(FG2{p.in[I_G2]}, (bf16_t*)(ws + WS_WG2), 1024, 256, ldsf);
    transpose_cvt(FPlain{p.in[I_WO], 1024}, (bf16_t*)(ws + WS_WO), 1024, 1024, ldsf);
    transpose_cvt(FLora2{p.in[I_W2]}, (bf16_t*)(ws + WS_W2T), 2048, 64, ldsf);
    transpose_cvt(FLora2{p.in[I_A2]}, (bf16_t*)(ws + WS_A2T), 2048, 64, ldsf);
    transpose_cvt(FPlain{p.in[I_HWIN], 3072}, (bf16_t*)(ws + WS_WIN), 3072, 1024, ldsf);
    transpose_cvt(FPlain{p.in[I_HWOUT], 1024}, (bf16_t*)(ws + WS_WOUT), 1024, 1024, ldsf);
    mod_phase(p, (float*)(ws + WS_MOD), ldsf);
    __syncthreads();
    hid_phase(p, (float*)(ws + WS_HID2), (float2*)(ws + WS_TW), ldsf);
}

typedef const __attribute__((address_space(4))) Params* CParamsPtr;
__device__ __forceinline__ const Params& kparams() {
    unsigned long long v = (unsigned long long)__builtin_amdgcn_kernarg_segment_ptr();
    asm volatile("" : "+s"(v));
    return *(const Params*)(CParamsPtr)v;
}
#define PH_BEGIN { const Params& p = kparams(); unsigned char* ws = p.ws; float* xl = p.out; float* xc = (float*)(ws + WS_XC); const float* mod0 = (const float*)(ws + WS_MOD); const float* mod1 = mod0 + 5 * 9216; \
    const float* ng = p.in[I_NORMG]; bf16_t* R1 = (bf16_t*)(ws + WS_R1); bf16_t* R2 = (bf16_t*)(ws + WS_R2); bf16_t* R3 = (bf16_t*)(ws + WS_R3); \
    const bf16_t* WGU = (const bf16_t*)(ws + WS_WGU); const bf16_t* WDN = (const bf16_t*)(ws + WS_WDN); const size_t EGU = SZ_WGU / 2, EDN = SZ_WDN / 2; \
    (void)xl; (void)xc; (void)mod0; (void)mod1; (void)ng; (void)R1; (void)R2; (void)R3; (void)WGU; (void)WDN; (void)EGU; (void)EDN;
#define PH_END } grid.sync();
__global__ void __launch_bounds__(NT, 2) fwd_megakernel(Params p_unused) {
    extern __shared__ __attribute__((aligned(16))) unsigned char lds_raw[];
    cg::grid_group grid = cg::this_grid();
    LAS unsigned char* lds = (LAS unsigned char*)lds_raw;
    float* ldsf = (float*)lds_raw;

    PH_BEGIN prep_phase(p, ws, ldsf); PH_END
    PH_BEGIN prenorm_phase(p.in[I_X], p.in[I_CTX], ng, mod0, 0, 1, R1, 1024, MALL); PH_END
    PH_BEGIN run_gemm(lds, R1, WGU, MALL, 5632, 1024, EpiSwiglu{R2}); PH_END
    PH_BEGIN run_gemm(lds, R2, WDN, MALL, 1024, 2816, EpiResid{p.in[I_X], xl, p.in[I_CTX], xc, mod0, 2, 0.5f}); PH_END
    PH_BEGIN prenorm_phase(xl, xc, ng + 1024, mod0, 3, 4, R1, 2048, MALL); PH_END
    PH_BEGIN dshift_phase(R1); PH_END
    PH_BEGIN run_gemm(lds, R1, (const bf16_t*)(ws + WS_WRW), MALL, 3584, 2048, EpiRwkv{R2, R3}); PH_END
#ifndef NO_SCAN
    PH_BEGIN scan_phase(p, ws, ldsf); PH_END
#endif
    PH_BEGIN post_phase(p, ws); PH_END
    PH_BEGIN run_gemm(lds, R3 + (size_t)MALL * 256, (const bf16_t*)(ws + WS_WG2), MLAT, 1024, 256, EpiG{R2, R2 + (size_t)MALL * 1024}); PH_END
    PH_BEGIN run_gemm(lds, R2 + (size_t)MALL * 1024, (const bf16_t*)(ws + WS_WO), MLAT, 1024, 1024, EpiResid{xl, xl, nullptr, nullptr, mod0, 5, 1.0f}); PH_END
    PH_BEGIN prenorm_phase(xl, xc, ng + 2048, mod0, 6, 7, R1, 1024, MLAT); PH_END
    PH_BEGIN run_gemm(lds, R1, WGU + EGU, MLAT, 5632, 1024, EpiSwiglu{R2}); PH_END
    PH_BEGIN run_gemm(lds, R2, WDN + EDN, MLAT, 1024, 2816, EpiResid{xl, xl, nullptr, nullptr, mod0, 8, 0.5f}); PH_END
    PH_BEGIN prenorm_phase(xl, xc, ng + 3072, mod1, 0, 1, R1, 1024, MLAT); PH_END
    PH_BEGIN run_gemm(lds, R1, WGU + 2 * EGU, MLAT, 5632, 1024, EpiSwiglu{R2}); PH_END
    PH_BEGIN run_gemm(lds, R2, WDN + 2 * EDN, MLAT, 1024, 2816, EpiResid{xl, xl, nullptr, nullptr, mod1, 2, 0.5f}); PH_END
    PH_BEGIN prenorm_phase(xl, xc, ng + 4096, mod1, 3, 4, R1, 1024, MLAT); PH_END
    PH_BEGIN run_gemm(lds, (const bf16_t*)(ws + WS_WIN), R1, 3072, MLAT, 1024, EpiBf16Plain{R2, MLAT}); PH_END
#ifndef NO_FFT
    PH_BEGIN fftconv_phase(p, ws, (float2*)lds_raw); PH_END
#endif
    PH_BEGIN transpose_phase(R1, R2, (unsigned short*)lds_raw); PH_END
    PH_BEGIN run_gemm(lds, R2, (const bf16_t*)(ws + WS_WOUT), MLAT, 1024, 1024, EpiResid{xl, xl, nullptr, nullptr, mod1, 5, 1.0f}); PH_END
    PH_BEGIN prenorm_phase(xl, xc, ng + 5120, mod1, 6, 7, R1, 1024, MLAT); PH_END
    PH_BEGIN run_gemm(lds, R1, WGU + 3 * EGU, MLAT, 5632, 1024, EpiSwiglu{R2}); PH_END
    PH_BEGIN run_gemm(lds, R2, WDN + 3 * EDN, MLAT, 1024, 2816, EpiResid{xl, xl, nullptr, nullptr, mod1, 8, 0.5f}); PH_END
    { const Params& p = kparams(); final_norm_phase(p.out, p.in[I_FINALG]); }
}

extern "C" void kernel_launch(void* const* d_in, const int* in_sizes, int n_in, void* d_out, int out_size, void* d_ws, size_t ws_size, hipStream_t stream) {
    static int grid = 0;
    if (grid == 0) {
        if (n_in != 38 || ws_size < WS_END) { fprintf(stderr, "kernel_launch: unexpected n_in %d or ws_size %zu (< %zu)\n", n_in, ws_size, (size_t)WS_END); grid = -1; return; }
        int dev = 0, cus = 0, per_cu = 0;
        (void)hipGetDevice(&dev);
        (void)hipDeviceGetAttribute(&cus, hipDeviceAttributeMultiprocessorCount, dev);
        (void)hipFuncSetAttribute((const void*)fwd_megakernel, hipFuncAttributeMaxDynamicSharedMemorySize, LDS_BYTES);
        (void)hipOccupancyMaxActiveBlocksPerMultiprocessor(&per_cu, (const void*)fwd_megakernel, NT, LDS_BYTES);
        if (per_cu < 1) { fprintf(stderr, "kernel_launch: occupancy query says %d blocks/CU\n", per_cu); per_cu = 1; }
        (void)hipGetLastError();
        grid = cus;
    }
    if (grid < 0) return;
    Params p{};
    for (int i = 0; i < 38; ++i) p.in[i] = (const float*)d_in[i];
    p.out = (float*)d_out; p.ws = (unsigned char*)d_ws;
    void* args[] = {&p};
    hipError_t e = hipLaunchCooperativeKernel((void*)fwd_megakernel, dim3(grid), dim3(NT), args, LDS_BYTES, stream);
    if (e != hipSuccess) fprintf(stderr, "cooperative launch failed: %s (grid %d)\n", hipGetErrorString(e), grid);
}
```

```cpp
#include <hip/hip_runtime.h>
#include <hip/hip_cooperative_groups.h>
#include <cstdio>
namespace cg = cooperative_groups;
#define XB_TMO      128
#define XB_XCNT(j)  (256  + 64 * (j))
#define XB_XSUB(j)  (1280 + 64 * (j))
#define XB_XGEN(j)  (2304 + 64 * (j))
#define XB_TOP      3328
#define XB_TOPGEN   3392
#define XCD_BAR_WORDS 3456
#define XB_SPIN_CAP (1u << 18)
#define LAS __attribute__((address_space(3)))

__device__ __forceinline__ unsigned xb_ld(unsigned* p)              { return __hip_atomic_load(p, __ATOMIC_RELAXED, __HIP_MEMORY_SCOPE_AGENT); }
__device__ __forceinline__ unsigned xb_add(unsigned* p, unsigned v) { return __hip_atomic_fetch_add(p, v, __ATOMIC_RELAXED, __HIP_MEMORY_SCOPE_AGENT); }
__device__ __forceinline__ unsigned xb_xcc_id() { return (unsigned)__builtin_amdgcn_s_getreg((3 << 11) | 20) & 0xFu; }
#define XB_SPIN(cond, bar) do { unsigned _sp = 0; while (cond) { __builtin_amdgcn_s_sleep(1); \
    if ((++_sp & 255u) == 0u) { if (xb_ld(&(bar)[XB_TMO])) break; if (_sp > XB_SPIN_CAP) { atomicAdd(&(bar)[XB_TMO], 1u); break; } } } } while (0)

struct XcdBarrier {
    unsigned* bar; unsigned x;
    volatile LAS unsigned* st;
};

__device__ __forceinline__ XcdBarrier xcd_barrier_post(unsigned* bar, volatile LAS unsigned* st) {
    XcdBarrier b; b.bar = bar; b.x = xb_xcc_id(); b.st = st;
    if (threadIdx.x == 0) (void)xb_add(&bar[XB_XCNT(b.x)], 1u);
    return b;
}
__device__ __forceinline__ void xcd_barrier_complete(unsigned* bar, unsigned x, unsigned& nloc, unsigned& nx) {
    const unsigned G = gridDim.x * gridDim.y * gridDim.z;
    unsigned sum, cnt, mine, sp = 0u;
    for (;;) {
        sum = 0u; cnt = 0u; mine = 0u;
#pragma unroll
        for (unsigned j = 0; j < 16; ++j) { const unsigned c = xb_ld(&bar[XB_XCNT(j)]); sum += c; cnt += (c > 0u) ? 1u : 0u; mine = (j == x) ? c : mine; }
        if (sum == G) break;
        __builtin_amdgcn_s_sleep(1);
        if ((++sp & 255u) == 0u) { if (xb_ld(&bar[XB_TMO])) break; if (sp > XB_SPIN_CAP) { atomicAdd(&bar[XB_TMO], 1u); break; } }
    }
    nloc = mine > 0u ? mine : 1u; nx = cnt > 0u ? cnt : 1u;
}

__device__ __forceinline__ void xcd_barrier(const XcdBarrier& b) {
    asm volatile("s_waitcnt vmcnt(0)" ::: "memory");
    __syncthreads();
    if (threadIdx.x == 0) {
        unsigned* bar = b.bar;
        __builtin_amdgcn_s_waitcnt(0);
        unsigned nloc = b.st[0], nx = b.st[1];
        if (nloc == 0u) { xcd_barrier_complete(bar, b.x, nloc, nx); b.st[0] = nloc; b.st[1] = nx; }
        const unsigned old = xb_add(&bar[XB_XSUB(b.x)], 1u);
        const unsigned gen = old / nloc;
        if (old + 1u == (gen + 1u) * nloc) {
            __builtin_amdgcn_fence(__ATOMIC_RELEASE, "agent");
            asm volatile("s_waitcnt vmcnt(0)" ::: "memory");
            const unsigned og = xb_add(&bar[XB_TOP], 1u);
            const unsigned tg = og / nx;
            if (og + 1u == (tg + 1u) * nx) xb_add(&bar[XB_TOPGEN], 1u);
            else XB_SPIN(xb_ld(&bar[XB_TOPGEN]) == tg, bar);
            __builtin_amdgcn_fence(__ATOMIC_ACQUIRE, "agent");
            xb_add(&bar[XB_XGEN(b.x)], 1u);
            asm volatile("s_waitcnt vmcnt(0)" ::: "memory");
        } else {
            XB_SPIN(xb_ld(&bar[XB_XGEN(b.x)]) == gen, bar);
            __builtin_amdgcn_fence(__ATOMIC_ACQUIRE, "agent");
            asm volatile("s_waitcnt vmcnt(0)" ::: "memory");
        }
    }
    __syncthreads();
}
namespace pg8 {
#define PG8_LAS __attribute__((address_space(3)))
typedef unsigned short bf16_t;
typedef short bf16x8 __attribute__((ext_vector_type(8)));
typedef float f32x4 __attribute__((ext_vector_type(4)));
typedef unsigned u32x4 __attribute__((ext_vector_type(4)));
constexpr int BM = 256, BK = 64, HALF = 128, HTB = HALF * BK * 2  , STAGE_BYTES = 8 * HTB, NXCD = 8, WGM = 8;

__host__ __device__ __forceinline__ int lds_byte(int r, int c) { const int st = (r >> 4) * 2 + (c >> 5), rr = r & 15, cc = c & 31, ob = rr * 64 + cc * 2; return st * 1024 + (ob ^ (((ob >> 9) & 1) << 5)); }
__host__ __device__ __forceinline__ void stage_rc(int b, int& R, int& C) { const int st = b / 1024, sb = b % 1024, swz = sb ^ (((sb >> 9) & 1) << 5); R = (st >> 1) * 16 + swz / 64; C = (st & 1) * 32 + (swz % 64) / 2; }
__host__ __device__ __forceinline__ int perm32(int rho) { const int n = rho >> 4, i = rho & 15; return 8 * (i >> 2) + 4 * n + (i & 3); }

struct Unit { int pm, pn; };
struct Gemm { const bf16_t* A; const bf16_t* Bt; int M, N, K; };

struct StaticOrder {
    int nM, nN, nwg, G, c;
    __host__ __device__ void init(int M, int N, int G_, int c_) { nM = M / BM; nN = N / BM; nwg = nM * nN; G = G_; c = c_; }
    __host__ __device__ bool next(int i, Unit& u) const {
        const long L = (long)i * G + c; if (L >= nwg) return false;
        int wgid = (int)L; { const int q = nwg / NXCD, r = nwg % NXCD, xcd = wgid % NXCD, off = wgid / NXCD; wgid = (xcd < r ? xcd * (q + 1) : r * (q + 1) + (xcd - r) * q) + off; }
        const int nig = WGM * nN, gid = wgid / nig, fm = gid * WGM, gsz = (nM - fm) < WGM ? (nM - fm) : WGM;
        u.pm = fm + ((wgid % nig) % gsz); u.pn = (wgid % nig) / gsz; return true;
    }
    __device__ __forceinline__ void a_ready(const Unit&) const {}
    __device__ __forceinline__ void done(const Unit&) const {}
};
__device__ __forceinline__ unsigned cvt_pk_bf16(float lo, float hi) { unsigned r; asm volatile("v_cvt_pk_bf16_f32 %0, %1, %2" : "=v"(r) : "v"(lo), "v"(hi)); return r; }
template <class Epi, class Sched, bool STAMP = false>
__device__ __forceinline__ void gemm_phase(PG8_LAS unsigned char* lds, const Gemm g, const Sched& S, const Epi& E, unsigned long long* stamps) {
    int tid_l = threadIdx.x; asm volatile("" : "+v"(tid_l));
    const int tid = tid_l, wid = __builtin_amdgcn_readfirstlane(tid >> 6), lane = tid & 63, wr = wid >> 2, wc = wid & 3, fr = lane & 15, fq = lane >> 4;
    const int K = g.K, nt = K / BK;
    int ts_lo = 0, ts_hi = 0, nts = 0; const unsigned long long rt_entry = STAMP ? (unsigned long long)wall_clock64() : 0ull;
#define PG8_STAMP() do { if (STAMP && wid == 0 && nts < 64) { const unsigned long long _c = (unsigned long long)clock64(); \
        ts_lo = (lane == nts) ? (int)(unsigned)_c : ts_lo; ts_hi = (lane == nts) ? (int)(unsigned)(_c >> 32) : ts_hi; ++nts; } } while (0)
    PG8_STAMP();
    unsigned voffA[2], voffB[2];
#pragma unroll
    for (int i = 0; i < 2; ++i) { int R, C; stage_rc(tid * 16 + i * 8192, R, C); const int Rb = Epi::PERM ? ((R & ~31) + perm32(R & 31)) : R;
        voffA[i] = (unsigned)(R * K + C) * 2u; voffB[i] = (unsigned)(Rb * K + C) * 2u; }
    const size_t kstep = (size_t)(BK * 2);
    const size_t hstep = (size_t)HALF * K * 2;
    const size_t tstep = 2 * hstep;
    const unsigned ldsw = (unsigned)wid * 1024u;
    const int aoff = lds_byte(wr * 64 + fr, fq * 8), boff = lds_byte(wc * 32 + fr, fq * 8);
#define PG8_SA(b, h) (((b) * 2 + (h)) * HTB)
#define PG8_SB(b, h) ((4 + (b) * 2 + (h)) * HTB)
#define PG8_STAGE(bufoff, gbase, voff) do { _Pragma("unroll") for (int _i = 0; _i < 2; ++_i) \
        __builtin_amdgcn_global_load_lds((const unsigned*)((const char*)(gbase) + (voff)[_i]), (PG8_LAS unsigned*)(lds + (bufoff) + ldsw + _i * 8192), 16, 0, 0); } while (0)
#define PG8_LDA(dst, b, h) do { _Pragma("unroll") for (int m = 0; m < 4; ++m) _Pragma("unroll") for (int k = 0; k < 2; ++k) dst[m][k] = *(const PG8_LAS bf16x8*)(lds + PG8_SA(b, h) + aoff + m * 2048 + k * 1024); } while (0)
#define PG8_LDB(dst, b, h) do { _Pragma("unroll") for (int n = 0; n < 2; ++n) _Pragma("unroll") for (int k = 0; k < 2; ++k) dst[n][k] = *(const PG8_LAS bf16x8*)(lds + PG8_SB(b, h) + boff + n * 2048 + k * 1024); } while (0)
#define PG8_MMA(ai, bj, At, Bt) do { __builtin_amdgcn_s_setprio(1); _Pragma("unroll") for (int m = 0; m < 4; ++m) _Pragma("unroll") for (int n = 0; n < 2; ++n) _Pragma("unroll") for (int k = 0; k < 2; ++k) \
        acc[ai][bj][m][n] = __builtin_amdgcn_mfma_f32_16x16x32_bf16(Bt[n][k], At[m][k], acc[ai][bj][m][n], 0, 0, 0); __builtin_amdgcn_s_setprio(0); } while (0)
#define PG8_WAIT_V(n) asm volatile("s_waitcnt vmcnt(" #n ")" ::: "memory")
#define PG8_WAIT_L(n) asm volatile("s_waitcnt lgkmcnt(" #n ")" ::: "memory")
#define PG8_BAR __builtin_amdgcn_s_barrier()
#define PG8_SCHED __builtin_amdgcn_sched_barrier(0)
    Unit cur, nxt; int ui = 0;
    if (!S.next(0, cur)) return;
    f32x4 acc[2][2][4][2];
#pragma unroll
    for (int a = 0; a < 2; ++a)
#pragma unroll
        for (int b = 0; b < 2; ++b)
#pragma unroll
            for (int m = 0; m < 4; ++m)
#pragma unroll
                for (int n = 0; n < 2; ++n) acc[a][b][m][n] = (f32x4){0.f, 0.f, 0.f, 0.f};
    bf16x8 At[4][2], B0[2][2], B1[2][2];
    const char* cA = (const char*)g.A + (size_t)cur.pm * tstep; const char* cB = (const char*)g.Bt + (size_t)cur.pn * tstep;
    S.a_ready(cur);
    PG8_STAGE(PG8_SB(0, 0), cB, voffB); PG8_STAGE(PG8_SA(0, 0), cA, voffA); PG8_STAGE(PG8_SB(0, 1), cB + hstep, voffB); PG8_STAGE(PG8_SA(0, 1), cA + hstep, voffA);
    if (wr == 1) PG8_BAR;
    PG8_WAIT_V(4); PG8_BAR;
    PG8_STAGE(PG8_SB(1, 0), cB + kstep, voffB); PG8_STAGE(PG8_SA(1, 0), cA + kstep, voffA); PG8_STAGE(PG8_SB(1, 1), cB + hstep + kstep, voffB);
    PG8_WAIT_V(6); PG8_BAR;
    PG8_STAMP();
    for (;;) {
        const bool has_next = S.next(ui + 1, nxt);
        const char* nA = has_next ? (const char*)g.A + (size_t)nxt.pm * tstep : cA; const char* nB = has_next ? (const char*)g.Bt + (size_t)nxt.pn * tstep : cB;
        for (int t = 0; t < nt; t += 2) {
            const bool last = (t == nt - 2);
            const char* a1 = cA + (size_t)(t + 1) * kstep;
            const char* a2 = last ? nA : cA + (size_t)(t + 2) * kstep; const char* b2 = last ? nB : cB + (size_t)(t + 2) * kstep;
            const char* a3 = a2 + kstep; const char* b3 = b2 + kstep;
            if (last && has_next) S.a_ready(nxt);
            PG8_LDB(B0, 0, 0); PG8_SCHED; PG8_LDA(At, 0, 0); PG8_STAGE(PG8_SA(1, 1), a1 + hstep, voffA);
            PG8_WAIT_L(8); PG8_BAR; PG8_WAIT_L(0); PG8_MMA(0, 0, At, B0); PG8_BAR; PG8_SCHED;
            PG8_LDB(B1, 0, 1); PG8_STAGE(PG8_SB(0, 0), b2, voffB);
            PG8_BAR; PG8_WAIT_L(0); PG8_MMA(0, 1, At, B1); PG8_BAR;
            PG8_LDA(At, 0, 1); PG8_STAGE(PG8_SA(0, 0), a2, voffA);
            PG8_BAR; PG8_WAIT_L(0); PG8_MMA(1, 0, At, B0); PG8_BAR; PG8_SCHED;
            PG8_STAGE(PG8_SB(0, 1), b2 + hstep, voffB);
            PG8_WAIT_V(6); PG8_BAR; PG8_MMA(1, 1, At, B1); PG8_BAR;
            PG8_LDB(B0, 1, 0); PG8_SCHED; PG8_LDA(At, 1, 0); PG8_STAGE(PG8_SA(0, 1), a2 + hstep, voffA);
            PG8_WAIT_L(8); PG8_BAR; PG8_WAIT_L(0); PG8_MMA(0, 0, At, B0); PG8_BAR; PG8_SCHED;
            PG8_LDB(B1, 1, 1); PG8_STAGE(PG8_SB(1, 0), b3, voffB);
            PG8_BAR; PG8_WAIT_L(0); PG8_MMA(0, 1, At, B1); PG8_BAR;
            PG8_LDA(At, 1, 1); PG8_STAGE(PG8_SA(1, 0), a3, voffA);
            PG8_BAR; PG8_WAIT_L(0); PG8_MMA(1, 0, At, B0); PG8_BAR; PG8_SCHED;
            PG8_STAGE(PG8_SB(1, 1), b3 + hstep, voffB);
            PG8_WAIT_V(6); PG8_BAR; PG8_MMA(1, 1, At, B1); PG8_BAR;
        }
        PG8_STAMP();
        if constexpr (!Epi::AFTER_DRAIN) { E(acc, cur, wr, wc, fr, fq); S.done(cur); }
        PG8_STAMP();
        if (!has_next) break;
#pragma unroll
        for (int a = 0; a < 2; ++a)
#pragma unroll
            for (int b = 0; b < 2; ++b)
#pragma unroll
                for (int m = 0; m < 4; ++m)
#pragma unroll
                    for (int n = 0; n < 2; ++n) acc[a][b][m][n] = (f32x4){0.f, 0.f, 0.f, 0.f};
        cur = nxt; cA = nA; cB = nB; ++ui;
    }
    PG8_WAIT_V(0);
    if (wr == 0) PG8_BAR;
    PG8_BAR;
    if constexpr (Epi::AFTER_DRAIN) { E.fused(acc, cur, wr, wc, fr, fq, lds, wid, lane); S.done(cur); }
    PG8_STAMP();
    if (STAMP && wid == 0) { stamps[lane] = lane < nts ? (((unsigned long long)(unsigned)ts_hi << 32) | (unsigned)ts_lo) : 0ull;
        if (lane == 62) stamps[62] = rt_entry; if (lane == 63) stamps[63] = (unsigned long long)wall_clock64(); }
#undef PG8_STAMP
#undef PG8_SA
#undef PG8_SB
#undef PG8_STAGE
#undef PG8_LDA
#undef PG8_LDB
#undef PG8_MMA
#undef PG8_WAIT_V
#undef PG8_WAIT_L
#undef PG8_BAR
#undef PG8_SCHED
}
}
using pg8::bf16_t; using pg8::bf16x8; using pg8::f32x4; using pg8::Unit;
#define LAS __attribute__((address_space(3)))

constexpr int D = 1024, NB = 4, SEQ = 8192, MLAT = NB * SEQ, CTXL = 256, MCTX = NB * CTXL, MALL = MLAT + MCTX;
constexpr int FF = 2816, NT = 512;
constexpr int LDS_BYTES = 147456;

constexpr size_t al256(size_t x) { return (x + 255) & ~(size_t)255; }
constexpr size_t SZ_WGU = (size_t)5632 * 1024 * 2, SZ_WDN = (size_t)1024 * 2816 * 2;
constexpr size_t WS_WGU = 0;
constexpr size_t WS_WDN = WS_WGU + 4 * SZ_WGU;
constexpr size_t WS_WRW = WS_WDN + 4 * SZ_WDN;
constexpr size_t WS_WG2 = WS_WRW + (size_t)3584 * 2048 * 2;
constexpr size_t WS_WO = WS_WG2 + (size_t)1024 * 256 * 2;
constexpr size_t WS_W2T = WS_WO + (size_t)1024 * 1024 * 2;
constexpr size_t WS_A2T = WS_W2T + (size_t)2 * 1024 * 64 * 2;
constexpr size_t WS_WIN = WS_A2T + (size_t)2 * 1024 * 64 * 2;
constexpr size_t WS_WOUT = WS_WIN + (size_t)3072 * 1024 * 2;
constexpr size_t WS_MOD = WS_WOUT + (size_t)1024 * 1024 * 2;
constexpr size_t WS_HID2 = WS_MOD + al256((size_t)2 * 5 * 9216 * 4);
constexpr size_t WS_W3T = WS_HID2 + (size_t)8192 * 256 * 2;
constexpr size_t WS_XC = WS_W3T + (size_t)2048 * 256 * 2;
constexpr size_t WS_BSUM = WS_XC + (size_t)1024 * 1024 * 4;
constexpr size_t WS_R1 = WS_BSUM + (size_t)2 * 32768 * 16 * 4;
constexpr size_t SZ_R1 = (size_t)MALL * 2048 * 2;
constexpr size_t WS_R2 = WS_R1 + SZ_R1;
constexpr size_t SZ_R2 = (size_t)MALL * 1024 * 2 * 3;
constexpr size_t WS_R3 = WS_R2 + SZ_R2;
constexpr size_t SZ_R3 = (size_t)MALL * 512 * 2;
constexpr size_t WS_BAR = WS_R3 + SZ_R3;
constexpr size_t WS_END = WS_BAR + (size_t)XCD_BAR_WORDS * 4;

struct Params { const float* in[38]; float* out; unsigned char* ws; };
enum { I_X = 0, I_C, I_CTX, I_CCTX, I_MODW, I_MODB, I_NORMG, I_WGU, I_WDN, I_MIX, I_WRKV, I_WO, I_W0, I_W1, I_W2, I_A0, I_A1, I_A2, I_G1, I_G2,
       I_KK, I_KA, I_RK, I_LNG, I_LNB, I_HWIN, I_HCW, I_HCB, I_FW1, I_FB1, I_FFREQ, I_FW2, I_FB2, I_FW3, I_DELTAS, I_HBIAS, I_HWOUT, I_FINALG };

__device__ __forceinline__ int ltid() { int t = threadIdx.x; asm volatile("" : "+v"(t)); return t; }
__device__ __forceinline__ float bf2f(unsigned short b) { return __uint_as_float(((unsigned)b) << 16); }
__device__ __forceinline__ float bflo(unsigned u) { return __uint_as_float(u << 16); }
__device__ __forceinline__ float bfhi(unsigned u) { return __uint_as_float(u & 0xffff0000u); }
typedef __bf16 bf2_t __attribute__((ext_vector_type(2)));
typedef float f2_t __attribute__((ext_vector_type(2)));
__device__ __forceinline__ unsigned pk2(float lo, float hi) { const f2_t f = {lo, hi}; const bf2_t b = __builtin_convertvector(f, bf2_t); return __builtin_bit_cast(unsigned, b); }
__device__ __forceinline__ float frcp(float x) { return __builtin_amdgcn_rcpf(x); }
__device__ __forceinline__ float sigm(float x) { return frcp(1.f + __expf(-x)); }
__device__ __forceinline__ float wave_sum(float v) {
#pragma unroll
    for (int o = 32; o >= 1; o >>= 1) v += __shfl_xor(v, o, 64);
    return v;
}

__device__ __forceinline__ void grid_barrier(unsigned* ctr, unsigned& epoch) {
    asm volatile("s_waitcnt vmcnt(0) lgkmcnt(0)" ::: "memory");
    __syncthreads();
    epoch += 1u;
    if (threadIdx.x == 0) {
        __builtin_amdgcn_fence(__ATOMIC_RELEASE, "agent");
        asm volatile("s_waitcnt vmcnt(0)" ::: "memory");
        __hip_atomic_fetch_add(ctr, 1u, __ATOMIC_RELAXED, __HIP_MEMORY_SCOPE_AGENT);
        const unsigned target = epoch * gridDim.x;
        while (__hip_atomic_load(ctr, __ATOMIC_RELAXED, __HIP_MEMORY_SCOPE_AGENT) < target) __builtin_amdgcn_s_sleep(1);
    }
    __syncthreads();
    __builtin_amdgcn_fence(__ATOMIC_ACQUIRE, "agent");
    asm volatile("s_waitcnt vmcnt(0)" ::: "memory");
}

template <class F> __device__ void transpose_cvt(const F f, bf16_t* dst, int N, int K, float* tile) {
    const int tid = ltid(), ntn = N >> 6, ntk = K >> 6;
    for (int t = blockIdx.x; t < ntn * ntk; t += gridDim.x) {
        const int tn = t % ntn, tk = t / ntn, n0 = tn * 64, k0 = tk * 64;
#pragma unroll
        for (int i = 0; i < 8; ++i) { const int r = (tid >> 6) + 8 * i, c = tid & 63; tile[r * 65 + c] = f(n0 + c, k0 + r); }
        __syncthreads();
#pragma unroll
        for (int i = 0; i < 4; ++i) { const int idx = tid + 512 * i, nn = idx >> 5, kp = idx & 31;
            *(unsigned*)(dst + (size_t)(n0 + nn) * K + k0 + 2 * kp) = pk2(tile[(2 * kp) * 65 + nn], tile[(2 * kp + 1) * 65 + nn]); }
        __syncthreads();
    }
}
struct FGu { const float* w; __device__ float operator()(int n, int k) const { const int pn = n >> 8, r = n & 255; const int col = (r < 128) ? (pn * 128 + r) : (FF + pn * 128 + (r - 128)); return w[(size_t)k * 5632 + col]; } };
struct FPlain { const float* w; int ld; __device__ float operator()(int n, int k) const { return w[(size_t)k * ld + n]; } };
struct FRw { const float *rkv, *w1, *a1, *g1, *mix;
    __device__ float operator()(int n, int k) const {
        const int kk = k & 1023; float v; int mi;
        if (n < 3072) { const int j = n >> 10; v = rkv[((size_t)j * 1024 + kk) * 1024 + (n & 1023)]; mi = (j == 0) ? 0 : (j == 1 ? 2 : 3); }
        else if (n < 3200) { const int q = n - 3072; v = w1[((size_t)(q >> 6) * 1024 + kk) * 64 + (q & 63)]; mi = 1; }
        else if (n < 3328) { const int q = n - 3200; v = a1[((size_t)(q >> 6) * 1024 + kk) * 64 + (q & 63)]; mi = 4; }
        else if (n < 3488) { const int q = n - 3328; v = g1[(size_t)kk * 160 + q]; mi = 5; }
        else return 0.f;
        if (k >= 1024) v *= mix[mi * 1024 + kk];
        return v; } };
struct FG2 { const float* g2; __device__ float operator()(int n, int k) const { return k < 160 ? g2[(size_t)k * 1024 + n] : 0.f; } };
struct FLora2 { const float* w2; __device__ float operator()(int n, int k) const { const int dir = n >> 10; return w2[((size_t)dir * 64 + k) * 1024 + (n & 1023)]; } };

__device__ void mod_phase(const Params& p, float* mod, float* ldsf) {
    const int tid = ltid(), lane = tid & 63, wave = tid >> 6;
    float* sc = ldsf; float* red = ldsf + 5 * 1024;
    for (int i = tid; i < 5 * 1024; i += NT) { const int m = i >> 10, k = i & 1023; const float v = m < 4 ? p.in[I_C][m * 1024 + k] : p.in[I_CCTX][k]; sc[i] = v * sigm(v); }
    __syncthreads();
    const int kq = lane >> 4, cq = lane & 15;
    for (int cb = blockIdx.x; cb < 288; cb += gridDim.x) {
        const int layer = cb / 144, col0 = (cb % 144) * 64;
        const float* W = p.in[I_MODW] + (size_t)layer * 1024 * 9216;
        float acc[5][4];
#pragma unroll
        for (int m = 0; m < 5; ++m)
#pragma unroll
            for (int e = 0; e < 4; ++e) acc[m][e] = 0.f;
#pragma unroll 8
        for (int i = 0; i < 32; ++i) { const int k = wave * 128 + 4 * i + kq; const float4 w = *(const float4*)(W + (size_t)k * 9216 + col0 + 4 * cq);
#pragma unroll
            for (int m = 0; m < 5; ++m) { const float s = sc[m * 1024 + k]; acc[m][0] += s * w.x; acc[m][1] += s * w.y; acc[m][2] += s * w.z; acc[m][3] += s * w.w; } }
#pragma unroll
        for (int m = 0; m < 5; ++m)
#pragma unroll
            for (int e = 0; e < 4; ++e) { float a = acc[m][e]; a += __shfl_xor(a, 16, 64); a += __shfl_xor(a, 32, 64); if (kq == 0) red[(wave * 5 + m) * 64 + 4 * cq + e] = a; }
        __syncthreads();
        if (tid < 320) { const int m = tid >> 6, cc = tid & 63; float s = 0.f;
#pragma unroll
            for (int w = 0; w < 8; ++w) s += red[(w * 5 + m) * 64 + cc];
            mod[((size_t)layer * 5 + m) * 9216 + col0 + cc] = s + p.in[I_MODB][layer * 9216 + col0 + cc]; }
        __syncthreads();
    }
}

__device__ void hid_phase(const Params& p, bf16_t* hid2b, float* ldsf) {
    const int tid = ltid(), rr = tid >> 6, j = tid & 63;
    float* zs = ldsf; float* h1 = ldsf + 8 * 36;
    const float *w1 = p.in[I_FW1], *b1 = p.in[I_FB1], *fq = p.in[I_FFREQ], *w2 = p.in[I_FW2], *b2 = p.in[I_FB2];
    for (int it = blockIdx.x; it < 1024; it += gridDim.x) {
        const int l = it * 8 + rr;
        if (j < 33) { float z;
            if (j == 0) z = (float)l / 8191.f;
            else { const int bi = (j - 1) & 15; const float band = 1e-4f + (float)bi * ((15.f - 1e-4f) / 15.f); const float ang = (7.66990393942820614859e-4f * (float)l) * band; z = (j <= 16) ? cosf(ang) : -sinf(ang); }
            zs[rr * 36 + j] = z; }
        __syncthreads();
        float a = b1[j];
        for (int i = 0; i < 33; ++i) a += zs[rr * 36 + i] * w1[i * 64 + j];
        h1[rr * 64 + j] = sinf(fq[j] * a);
        __syncthreads();
        float a2 = b2[j];
        for (int i = 0; i < 64; ++i) a2 += h1[rr * 64 + i] * w2[i * 64 + j];
        bf16_t* o = hid2b + (size_t)l * 256 + j;
        o[0] = (bf16_t)(pk2(sinf(fq[64 + j] * a2), 0.f) & 0xffffu); o[64] = 0; o[128] = 0; o[192] = 0;
        __syncthreads();
    }
}
struct FW3 { const float* w3; __device__ float operator()(int n, int k) const { return k < 64 ? w3[(size_t)k * 2048 + n] : 0.f; } };

__device__ void prenorm_phase(const float* xl, const float* xc, const float* g, const float* mod, int ish, int isc, bf16_t* out, int out_ld, int nrows) {
    const int lane = ltid() & 63, gw = blockIdx.x * 8 + (ltid() >> 6), nw = gridDim.x * 8;
    for (int r = gw; r < nrows; r += nw) {
        const float* src = r < MLAT ? xl + (size_t)r * 1024 : xc + (size_t)(r - MLAT) * 1024;
        const int m = r < MLAT ? (r >> 13) : 4;
        const float* sh = mod + (size_t)m * 9216 + ish * 1024; const float* sc = mod + (size_t)m * 9216 + isc * 1024;
        float4 v[4]; float ss = 0.f;
#pragma unroll
        for (int i = 0; i < 4; ++i) { v[i] = *(const float4*)(src + 4 * (lane + 64 * i)); ss += v[i].x * v[i].x + v[i].y * v[i].y + v[i].z * v[i].z + v[i].w * v[i].w; }
        ss = wave_sum(ss);
        const float rstd = rsqrtf(ss * (1.f / 1024.f) + 1e-6f);
#pragma unroll
        for (int i = 0; i < 4; ++i) { const int c = 4 * (lane + 64 * i);
            const float4 g4 = *(const float4*)(g + c), s4 = *(const float4*)(sh + c), c4 = *(const float4*)(sc + c);
            const float o0 = v[i].x * rstd * g4.x * (1.f + c4.x) + s4.x, o1 = v[i].y * rstd * g4.y * (1.f + c4.y) + s4.y;
            const float o2 = v[i].z * rstd * g4.z * (1.f + c4.z) + s4.z, o3 = v[i].w * rstd * g4.w * (1.f + c4.w) + s4.w;
            uint2 o; o.x = pk2(o0, o1); o.y = pk2(o2, o3);
            *(uint2*)(out + (size_t)r * out_ld + c) = o; }
    }
}
__device__ void final_norm_phase(float* x, const float* g) {
    const int lane = ltid() & 63, gw = blockIdx.x * 8 + (ltid() >> 6), nw = gridDim.x * 8;
    for (int r = gw; r < MLAT; r += nw) {
        float* src = x + (size_t)r * 1024; float4 v[4]; float ss = 0.f;
#pragma unroll
        for (int i = 0; i < 4; ++i) { v[i] = *(const float4*)(src + 4 * (lane + 64 * i)); ss += v[i].x * v[i].x + v[i].y * v[i].y + v[i].z * v[i].z + v[i].w * v[i].w; }
        ss = wave_sum(ss);
        const float rstd = rsqrtf(ss * (1.f / 1024.f) + 1e-6f);
#pragma unroll
        for (int i = 0; i < 4; ++i) { const int c = 4 * (lane + 64 * i); const float4 g4 = *(const float4*)(g + c);
            float4 o; o.x = v[i].x * rstd * g4.x; o.y = v[i].y * rstd * g4.y; o.z = v[i].z * rstd * g4.z; o.w = v[i].w * rstd * g4.w;
            *(float4*)(src + c) = o; }
    }
}

struct EpiSwiglu {
    static constexpr bool PERM = true, AFTER_DRAIN = false;
    bf16_t* H;
    __device__ __forceinline__ void operator()(const f32x4 (&acc)[2][2][4][2], const Unit& u, int wr, int wc, int fr, int fq) const {
        const int row0 = u.pm * 256 + wr * 64 + fr, col0 = u.pn * 128 + wc * 32 + 8 * fq;
#pragma unroll
        for (int ai = 0; ai < 2; ++ai)
#pragma unroll
            for (int m = 0; m < 4; ++m) { const f32x4 g0 = acc[ai][0][m][0], g1 = acc[ai][0][m][1], u0 = acc[ai][1][m][0], u1 = acc[ai][1][m][1];
                float h[8];
#pragma unroll
                for (int e = 0; e < 4; ++e) { h[e] = g0[e] * sigm(g0[e]) * u0[e]; h[4 + e] = g1[e] * sigm(g1[e]) * u1[e]; }
                uint4 o; o.x = pk2(h[0], h[1]); o.y = pk2(h[2], h[3]); o.z = pk2(h[4], h[5]); o.w = pk2(h[6], h[7]);
                *(uint4*)(H + (size_t)(row0 + ai * 128 + m * 16) * FF + col0) = o; }
    }
};
struct EpiResid {
    static constexpr bool PERM = false, AFTER_DRAIN = false;
    const float* src_l; float* dst_l; const float* src_c; float* dst_c; const float* mod; int ig; float coef;
    __device__ __forceinline__ void operator()(const f32x4 (&acc)[2][2][4][2], const Unit& u, int wr, int wc, int fr, int fq) const {
        const bool lat = u.pm < 128; const float* src = lat ? src_l : src_c; float* dst = lat ? dst_l : dst_c;
        const int rbase = (lat ? u.pm : u.pm - 128) * 256 + wr * 64 + fr, mi = lat ? (u.pm >> 5) : 4, col0 = u.pn * 256 + wc * 32 + 4 * fq;
        const float* gp = mod + (size_t)mi * 9216 + ig * 1024 + col0;
        f32x4 gv[2][2];
#pragma unroll
        for (int bj = 0; bj < 2; ++bj)
#pragma unroll
            for (int n = 0; n < 2; ++n) gv[bj][n] = *(const f32x4*)(gp + bj * 128 + n * 16) * coef;
#pragma unroll
        for (int ai = 0; ai < 2; ++ai)
#pragma unroll
            for (int m = 0; m < 4; ++m) { const size_t ro = (size_t)(rbase + ai * 128 + m * 16) * 1024 + col0;
#pragma unroll
                for (int bj = 0; bj < 2; ++bj)
#pragma unroll
                    for (int n = 0; n < 2; ++n) { const size_t off = ro + bj * 128 + n * 16; const f32x4 s = *(const f32x4*)(src + off); *(f32x4*)(dst + off) = s + gv[bj][n] * acc[ai][bj][m][n]; } }
    }
};
template <class Epi> __device__ __forceinline__ void run_gemm(LAS unsigned char* lds, const bf16_t* A, const bf16_t* Bt, int M, int N, int K, const Epi& E) {
    asm volatile("" : "+s"(K));
    pg8::Gemm g{A, Bt, M, N, K}; pg8::StaticOrder S; S.init(M, N, (int)gridDim.x, (int)blockIdx.x);
    pg8::gemm_phase<Epi, pg8::StaticOrder, false>(lds, g, S, E, nullptr);
}
__device__ void dshift_phase(bf16_t* A2) {
    const int lane = ltid() & 63, gw = blockIdx.x * 8 + (ltid() >> 6), nw = gridDim.x * 8;
    for (int r = gw; r < MALL; r += nw) {
#pragma unroll
        for (int i = 0; i < 2; ++i) { const int c = 8 * (lane + 64 * i), q = c >> 8; int nb = -1;
            if (r < MLAT) { const int t = r & 8191, gy = t >> 6, gx = t & 63;
                if (q == 0) nb = gx > 0 ? r - 1 : -1; else if (q == 1) nb = gx < 63 ? r + 1 : -1; else if (q == 2) nb = gy > 0 ? r - 64 : -1; else nb = gy < 127 ? r + 64 : -1; }
            else { const int t = (r - MLAT) & 255; nb = ((q & 1) == 0) ? (t > 0 ? r - 1 : -1) : (t < 255 ? r + 1 : -1); }
            const uint4 hv = *(const uint4*)(A2 + (size_t)r * 2048 + c);
            uint4 nv = *(const uint4*)(A2 + (size_t)(nb >= 0 ? nb : r) * 2048 + c);
            if (nb < 0) nv = make_uint4(0u, 0u, 0u, 0u);
            uint4 o;
            o.x = pk2(bflo(nv.x) - bflo(hv.x), bfhi(nv.x) - bfhi(hv.x)); o.y = pk2(bflo(nv.y) - bflo(hv.y), bfhi(nv.y) - bfhi(hv.y));
            o.z = pk2(bflo(nv.z) - bflo(hv.z), bfhi(nv.z) - bfhi(hv.z)); o.w = pk2(bflo(nv.w) - bflo(hv.w), bfhi(nv.w) - bfhi(hv.w));
            *(uint4*)(A2 + (size_t)r * 2048 + 1024 + c) = o; }
    }
}
__device__ __forceinline__ uint4 pack8(const f32x4 a, const f32x4 b) { uint4 o; o.x = pk2(a[0], a[1]); o.y = pk2(a[2], a[3]); o.z = pk2(b[0], b[1]); o.w = pk2(b[2], b[3]); return o; }
__device__ __forceinline__ float tanh_(float x) { return 1.f - 2.f * frcp(1.f + __expf(2.f * x)); }
struct EpiRwkv {
    static constexpr bool PERM = true, AFTER_DRAIN = false;
    bf16_t *rkv, *l1;
    __device__ __forceinline__ void operator()(const f32x4 (&acc)[2][2][4][2], const Unit& u, int wr, int wc, int fr, int fq) const {
        const int row0 = u.pm * 256 + wr * 64 + fr, cw = wc * 32 + 8 * fq;
        bf16_t* const l1w = l1; bf16_t* const l1a = l1 + (size_t)MALL * 128; bf16_t* const l1g = l1 + (size_t)MALL * 256;
        const int mode = u.pn < 12 ? 0 : (u.pn == 12 ? 1 : 2);
        bf16_t* base0; bf16_t* base1; int ld;
        if (mode == 0) { base0 = rkv + (size_t)(u.pn >> 2) * ((size_t)MALL * 1024) + (u.pn & 3) * 256 + cw; base1 = base0 + 128; ld = 1024; }
        else if (mode == 1) { base0 = l1w + cw; base1 = l1a + cw; ld = 128; }
        else { base0 = l1g + cw; base1 = l1g + 128 + cw; ld = 256; }
#pragma unroll
        for (int ai = 0; ai < 2; ++ai)
#pragma unroll
            for (int m = 0; m < 4; ++m) { const size_t ro = (size_t)(row0 + ai * 128 + m * 16) * ld;
#pragma unroll
                for (int bj = 0; bj < 2; ++bj) { f32x4 t0 = acc[ai][bj][m][0], t1 = acc[ai][bj][m][1];
                    if (mode == 1 && bj == 0) {
#pragma unroll
                        for (int e = 0; e < 4; ++e) { t0[e] = tanh_(t0[e]); t1[e] = tanh_(t1[e]); } }
                    if (mode == 2) { const bool live = (bj * 128 + cw) < 160;
#pragma unroll
                        for (int e = 0; e < 4; ++e) { t0[e] = live ? sigm(t0[e]) : 0.f; t1[e] = live ? sigm(t1[e]) : 0.f; } }
                    *(uint4*)((bj ? base1 : base0) + ro) = pack8(t0, t1); } }
    }
};
struct EpiG {
    static constexpr bool PERM = true, AFTER_DRAIN = false;
    const bf16_t* yn; bf16_t* ao;
    __device__ __forceinline__ void operator()(const f32x4 (&acc)[2][2][4][2], const Unit& u, int wr, int wc, int fr, int fq) const {
        const int row0 = u.pm * 256 + wr * 64 + fr, col0 = u.pn * 256 + wc * 32 + 8 * fq;
#pragma unroll
        for (int ai = 0; ai < 2; ++ai)
#pragma unroll
            for (int m = 0; m < 4; ++m)
#pragma unroll
                for (int bj = 0; bj < 2; ++bj) { const size_t off = (size_t)(row0 + ai * 128 + m * 16) * 1024 + col0 + bj * 128;
                    const uint4 y = *(const uint4*)(yn + off); const f32x4 a0 = acc[ai][bj][m][0], a1 = acc[ai][bj][m][1];
                    uint4 o; o.x = pk2(bflo(y.x) * a0[0], bfhi(y.x) * a0[1]); o.y = pk2(bflo(y.y) * a0[2], bfhi(y.y) * a0[3]);
                    o.z = pk2(bflo(y.z) * a1[0], bfhi(y.z) * a1[1]); o.w = pk2(bflo(y.w) * a1[2], bfhi(y.w) * a1[3]);
                    *(uint4*)(ao + off) = o; asm volatile("" ::: "memory"); }
    }
};
struct EpiBf16Plain {
    static constexpr bool PERM = true, AFTER_DRAIN = false;
    bf16_t* O; int ld;
    __device__ __forceinline__ void operator()(const f32x4 (&acc)[2][2][4][2], const Unit& u, int wr, int wc, int fr, int fq) const {
        const int row0 = u.pm * 256 + wr * 64 + fr, col0 = u.pn * 256 + wc * 32 + 8 * fq;
#pragma unroll
        for (int ai = 0; ai < 2; ++ai)
#pragma unroll
            for (int m = 0; m < 4; ++m)
#pragma unroll
                for (int bj = 0; bj < 2; ++bj) *(uint4*)(O + (size_t)(row0 + ai * 128 + m * 16) * ld + col0 + bj * 128) = pack8(acc[ai][bj][m][0], acc[ai][bj][m][1]);
    }
};

#ifndef SCAN_DUP_LOADER
#define SCAN_DUP_LOADER 0
#endif
typedef float f2v __attribute__((ext_vector_type(2)));
template <int N> __device__ __forceinline__ float dpp_ror(float x) { return __int_as_float(__builtin_amdgcn_update_dpp(__float_as_int(x), __float_as_int(x), 0x120 + N, 0xf, 0xf, true)); }
__device__ __forceinline__ float row_allsum16(float x) { x += dpp_ror<8>(x); x += dpp_ror<4>(x); x += dpp_ror<2>(x); x += dpp_ror<1>(x); return x; }
__device__ __forceinline__ int scan_tokrow(int ci, int slot, int dir, int b) {
    if (ci < 4) { const int s = ci * 64 + slot; return MLAT + b * 256 + (dir ? 255 - s : s); }
    const int s = (ci - 4) * 64 + slot; return b * 8192 + (dir ? 8191 - s : s);
}
__device__ void scan_phase(const Params& p, unsigned char* ws, float* ldsf) {
    const int tid = ltid(), lane = tid & 63, wave = tid >> 6;
    const bf16_t* Rb = (const bf16_t*)(ws + WS_R2); const bf16_t* Kb = Rb + (size_t)MALL * 1024; const bf16_t* Vb = Kb + (size_t)MALL * 1024;
    const bf16_t* L1w = (const bf16_t*)(ws + WS_R3); const bf16_t* L1a = L1w + (size_t)MALL * 128;
    bf16_t* Yd = (bf16_t*)(ws + WS_R1);
    float* bsum = (float*)(ws + WS_BSUM);
    const bf16_t* w2t = (const bf16_t*)(ws + WS_W2T); const bf16_t* a2t = (const bf16_t*)(ws + WS_A2T);
    float* Wl = ldsf; float* KDl = ldsf + 4096; float* KKl = ldsf + 8192; float* KAl = ldsf + 12288; float* Rl = ldsf + 16384; float* Vl = ldsf + 20480; float* Yl = ldsf + 24576;
    for (int wi = blockIdx.x; wi < 256; wi += gridDim.x) {
        const int chain = wi >> 1, half = wi & 1, dir = chain >> 6, b = (chain >> 4) & 3, h = chain & 15;
        const int rr = tid >> 4, ks = tid & 15, slot2 = tid >> 3, cg8 = tid & 7, ch0 = h * 64 + 8 * cg8;
        const int mt = wave & 3, nh = wave >> 2, l15 = lane & 15, lq = lane >> 4;
        f2v S0 = {0.f, 0.f}, S1 = {0.f, 0.f}, S2 = {0.f, 0.f}, S3 = {0.f, 0.f};
        const int rp = (tid >> 4) & 15;
        float kkc[8], kac[8], rkc[8];
#pragma unroll
        for (int e = 0; e < 8; ++e) { kkc[e] = p.in[I_KK][ch0 + e]; kac[e] = p.in[I_KA][ch0 + e]; rkc[e] = p.in[I_RK][ch0 + e]; }
        bf16x8 bw[2][2], ba[2][2]; float w0v[2], a0v[2];
#pragma unroll
        for (int nt = 0; nt < 2; ++nt) { const int n = h * 64 + 32 * nh + 16 * nt + l15;
            w0v[nt] = p.in[I_W0][dir * 1024 + n]; a0v[nt] = p.in[I_A0][dir * 1024 + n];
#pragma unroll
            for (int k2 = 0; k2 < 2; ++k2) { bw[nt][k2] = *(const bf16x8*)(w2t + (size_t)(dir * 1024 + n) * 64 + k2 * 32 + lq * 8); ba[nt][k2] = *(const bf16x8*)(a2t + (size_t)(dir * 1024 + n) * 64 + k2 * 32 + lq * 8); } }
        bf16x8 paw[2], paa[2]; uint4 pk_, pv_, pr_;
#define SCAN_LOAD(ci) do { const int _ra = scan_tokrow((ci), 16 * mt + l15, dir, b); \
            paw[0] = *(const bf16x8*)(L1w + (size_t)_ra * 128 + dir * 64 + lq * 8); paw[1] = *(const bf16x8*)(L1w + (size_t)_ra * 128 + dir * 64 + 32 + lq * 8); \
            paa[0] = *(const bf16x8*)(L1a + (size_t)_ra * 128 + dir * 64 + lq * 8); paa[1] = *(const bf16x8*)(L1a + (size_t)_ra * 128 + dir * 64 + 32 + lq * 8); \
            const int _rb = scan_tokrow((ci), slot2, dir, b); \
            pk_ = *(const uint4*)(Kb + (size_t)_rb * 1024 + ch0); pv_ = *(const uint4*)(Vb + (size_t)_rb * 1024 + ch0); pr_ = *(const uint4*)(Rb + (size_t)_rb * 1024 + ch0); } while (0)
        SCAN_LOAD(0);
        for (int ci = 0; ci < 132; ++ci) {
            for (int lrep = 0; lrep < 1 + SCAN_DUP_LOADER; ++lrep) {
            {
                f32x4 cw[2], ca[2];
#pragma unroll
                for (int nt = 0; nt < 2; ++nt) { const f32x4 z = {0.f, 0.f, 0.f, 0.f};
                    cw[nt] = __builtin_amdgcn_mfma_f32_16x16x32_bf16(paw[0], bw[nt][0], z, 0, 0, 0); cw[nt] = __builtin_amdgcn_mfma_f32_16x16x32_bf16(paw[1], bw[nt][1], cw[nt], 0, 0, 0);
                    ca[nt] = __builtin_amdgcn_mfma_f32_16x16x32_bf16(paa[0], ba[nt][0], z, 0, 0, 0); ca[nt] = __builtin_amdgcn_mfma_f32_16x16x32_bf16(paa[1], ba[nt][1], ca[nt], 0, 0, 0); }
#pragma unroll
                for (int nt = 0; nt < 2; ++nt)
#pragma unroll
                    for (int j = 0; j < 4; ++j) { const int slot = 16 * mt + 4 * lq + j, chl = 32 * nh + 16 * nt + l15;
                        Wl[slot * 64 + chl] = __expf(-0.60653065971263342f * sigm(w0v[nt] + cw[nt][j]));
                        KAl[slot * 64 + chl] = sigm(a0v[nt] + ca[nt][j]); }
            }
            __syncthreads();
            {
                float k8[8], v8[8], r8[8];
                k8[0] = bflo(pk_.x); k8[1] = bfhi(pk_.x); k8[2] = bflo(pk_.y); k8[3] = bfhi(pk_.y); k8[4] = bflo(pk_.z); k8[5] = bfhi(pk_.z); k8[6] = bflo(pk_.w); k8[7] = bfhi(pk_.w);
                v8[0] = bflo(pv_.x); v8[1] = bfhi(pv_.x); v8[2] = bflo(pv_.y); v8[3] = bfhi(pv_.y); v8[4] = bflo(pv_.z); v8[5] = bfhi(pv_.z); v8[6] = bflo(pv_.w); v8[7] = bfhi(pv_.w);
                r8[0] = bflo(pr_.x); r8[1] = bfhi(pr_.x); r8[2] = bflo(pr_.y); r8[3] = bfhi(pr_.y); r8[4] = bflo(pr_.z); r8[5] = bfhi(pr_.z); r8[6] = bflo(pr_.w); r8[7] = bfhi(pr_.w);
                float kkr[8], ss = 0.f;
#pragma unroll
                for (int e = 0; e < 8; ++e) { kkr[e] = k8[e] * kkc[e]; ss += kkr[e] * kkr[e]; }
                ss += __shfl_xor(ss, 1, 64); ss += __shfl_xor(ss, 2, 64); ss += __shfl_xor(ss, 4, 64);
                const float rn = 1.f / fmaxf(sqrtf(ss), 1e-12f);
                const float4 a_lo = *(const float4*)(KAl + slot2 * 64 + 8 * cg8), a_hi = *(const float4*)(KAl + slot2 * 64 + 8 * cg8 + 4);
                const float av[8] = {a_lo.x, a_lo.y, a_lo.z, a_lo.w, a_hi.x, a_hi.y, a_hi.z, a_hi.w};
                float kd[8], kk[8], ka[8], bp = 0.f;
#pragma unroll
                for (int e = 0; e < 8; ++e) { kd[e] = k8[e] * (1.f + (av[e] - 1.f) * kac[e]); kk[e] = kkr[e] * rn; ka[e] = kk[e] * av[e]; bp += r8[e] * kd[e] * rkc[e]; }
                bp += __shfl_xor(bp, 1, 64); bp += __shfl_xor(bp, 2, 64); bp += __shfl_xor(bp, 4, 64);
                const int o = slot2 * 64 + 8 * cg8;
                *(float4*)(KDl + o) = make_float4(kd[0], kd[1], kd[2], kd[3]); *(float4*)(KDl + o + 4) = make_float4(kd[4], kd[5], kd[6], kd[7]);
                *(float4*)(KKl + o) = make_float4(kk[0], kk[1], kk[2], kk[3]); *(float4*)(KKl + o + 4) = make_float4(kk[4], kk[5], kk[6], kk[7]);
                *(float4*)(KAl + o) = make_float4(ka[0], ka[1], ka[2], ka[3]); *(float4*)(KAl + o + 4) = make_float4(ka[4], ka[5], ka[6], ka[7]);
                *(float4*)(Rl + o) = make_float4(r8[0], r8[1], r8[2], r8[3]); *(float4*)(Rl + o + 4) = make_float4(r8[4], r8[5], r8[6], r8[7]);
                *(float4*)(Vl + o) = make_float4(v8[0], v8[1], v8[2], v8[3]); *(float4*)(Vl + o + 4) = make_float4(v8[4], v8[5], v8[6], v8[7]);
                if (ci >= 4 && half == 0 && cg8 == 0) bsum[((size_t)dir * MLAT + scan_tokrow(ci, slot2, dir, b)) * 16 + h] = bp;
            }
            __syncthreads();
            }
            if (ci + 1 < 132) SCAN_LOAD(ci + 1);
            if (wave < 4) {
                float4 kkn = *(const float4*)(KKl + 4 * ks);
                f2v sa2 = S0 * kkn.x + S1 * kkn.y + S2 * kkn.z + S3 * kkn.w;
                sa2.x = row_allsum16(sa2.x); sa2.y = row_allsum16(sa2.y);
                f2v yk = {0.f, 0.f};
                float4 w4 = *(const float4*)(Wl + 4 * ks), ka4 = *(const float4*)(KAl + 4 * ks), kd4 = *(const float4*)(KDl + 4 * ks), r4 = *(const float4*)(Rl + 4 * ks);
                f2v v2 = {Vl[half * 32 + rp], Vl[half * 32 + rp + 16]};
                kkn = *(const float4*)(KKl + 64 + 4 * ks);
#pragma unroll 16
                for (int s = 0; s < 64; ++s) {
                    const int sn = (s + 1) & 63, sn2 = (s + 2) & 63;
                    const float4 w4n = *(const float4*)(Wl + sn * 64 + 4 * ks), ka4n = *(const float4*)(KAl + sn * 64 + 4 * ks);
                    const float4 kd4n = *(const float4*)(KDl + sn * 64 + 4 * ks), r4n = *(const float4*)(Rl + sn * 64 + 4 * ks);
                    const f2v v2n = {Vl[sn * 64 + half * 32 + rp], Vl[sn * 64 + half * 32 + rp + 16]};
                    const float4 kknn = *(const float4*)(KKl + sn2 * 64 + 4 * ks);
                    S0 = S0 * w4.x + (v2 * kd4.x - sa2 * ka4.x); S1 = S1 * w4.y + (v2 * kd4.y - sa2 * ka4.y);
                    S2 = S2 * w4.z + (v2 * kd4.z - sa2 * ka4.z); S3 = S3 * w4.w + (v2 * kd4.w - sa2 * ka4.w);
                    f2v y2 = S0 * r4.x + S1 * r4.y + S2 * r4.z + S3 * r4.w;
                    f2v n2 = S0 * kkn.x + S1 * kkn.y + S2 * kkn.z + S3 * kkn.w;
                    { f2v t; t.x = dpp_ror<8>(n2.x); t.y = dpp_ror<8>(n2.y); n2 += t; t.x = dpp_ror<8>(y2.x); t.y = dpp_ror<8>(y2.y); y2 += t; }
                    { f2v t; t.x = dpp_ror<4>(n2.x); t.y = dpp_ror<4>(n2.y); n2 += t; t.x = dpp_ror<4>(y2.x); t.y = dpp_ror<4>(y2.y); y2 += t; }
                    { f2v t; t.x = dpp_ror<2>(n2.x); t.y = dpp_ror<2>(n2.y); n2 += t; t.x = dpp_ror<2>(y2.x); t.y = dpp_ror<2>(y2.y); y2 += t; }
                    { f2v t; t.x = dpp_ror<1>(n2.x); t.y = dpp_ror<1>(n2.y); n2 += t; t.x = dpp_ror<1>(y2.x); t.y = dpp_ror<1>(y2.y); y2 += t; }
                    sa2 = n2;
                    if ((s & 15) == ks) yk = y2;
                    if ((s & 15) == 15) { Yl[((s & 48) + ks) * 32 + rp] = yk.x; Yl[((s & 48) + ks) * 32 + rp + 16] = yk.y; }
                    w4 = w4n; ka4 = ka4n; kd4 = kd4n; r4 = r4n; v2 = v2n; kkn = kknn;
                }
            }
            __syncthreads();
            if (ci >= 4) { const float4 y4 = *(const float4*)(Yl + slot2 * 32 + 4 * cg8); const int row = scan_tokrow(ci, slot2, dir, b);
                uint2 o; o.x = pk2(y4.x, y4.y); o.y = pk2(y4.z, y4.w);
                *(uint2*)(Yd + ((size_t)dir * MLAT + row) * 1024 + h * 64 + half * 32 + 4 * cg8) = o; }
        }
#undef SCAN_LOAD
        __syncthreads();
    }
}
__device__ void post_tile(const Params& p, unsigned char* ws, int pm, int pn) {
    const int lane = ltid() & 63, wave = ltid() >> 6;
    const bf16_t* Yd = (const bf16_t*)(ws + WS_R1); const bf16_t* Vb = (const bf16_t*)(ws + WS_R2) + (size_t)2 * MALL * 1024;
    bf16_t* YN = (bf16_t*)(ws + WS_R2); const float* bsum = (const float*)(ws + WS_BSUM);
    const int c = pn * 256 + 4 * lane, head = c >> 6;
    float lg[4], lb[4];
#pragma unroll
    for (int e = 0; e < 4; ++e) { lg[e] = p.in[I_LNG][c + e]; lb[e] = p.in[I_LNB][c + e]; }
#pragma unroll 4
    for (int rr = wave; rr < 256; rr += 8) { const int r = pm * 256 + rr;
        const uint2 f = *(const uint2*)(Yd + (size_t)r * 1024 + c), bb = *(const uint2*)(Yd + ((size_t)MLAT + r) * 1024 + c), vv = *(const uint2*)(Vb + (size_t)r * 1024 + c);
        const float y0 = bflo(f.x) + bflo(bb.x), y1 = bfhi(f.x) + bfhi(bb.x), y2 = bflo(f.y) + bflo(bb.y), y3 = bfhi(f.y) + bfhi(bb.y);
        const float mu = row_allsum16(y0 + y1 + y2 + y3) * (1.f / 64.f);
        const float d0 = y0 - mu, d1 = y1 - mu, d2 = y2 - mu, d3 = y3 - mu;
        const float rs = rsqrtf(row_allsum16(d0 * d0 + d1 * d1 + d2 * d2 + d3 * d3) * (1.f / 64.f) + 64e-5f);
        const float bs = 0.5f * (bsum[(size_t)r * 16 + head] + bsum[((size_t)MLAT + r) * 16 + head]);
        uint2 o; o.x = pk2(d0 * rs * lg[0] + lb[0] + bs * bflo(vv.x), d1 * rs * lg[1] + lb[1] + bs * bfhi(vv.x));
        o.y = pk2(d2 * rs * lg[2] + lb[2] + bs * bflo(vv.y), d3 * rs * lg[3] + lb[3] + bs * bfhi(vv.y));
        *(uint2*)(YN + (size_t)r * 1024 + c) = o; }
}
__device__ void post_phase(const Params& p, unsigned char* ws) {
    const int lane = ltid() & 63, gw = blockIdx.x * 8 + (ltid() >> 6), nw = gridDim.x * 8;
    const bf16_t* Yd = (const bf16_t*)(ws + WS_R1); const bf16_t* Vb = (const bf16_t*)(ws + WS_R2) + (size_t)2 * MALL * 1024;
    bf16_t* YN = (bf16_t*)(ws + WS_R2); const float* bsum = (const float*)(ws + WS_BSUM);
    const int c0 = 16 * lane, head = lane >> 2;
    float lg[16], lb[16];
#pragma unroll
    for (int e = 0; e < 16; ++e) { lg[e] = p.in[I_LNG][c0 + e]; lb[e] = p.in[I_LNB][c0 + e]; }
    for (int r = gw; r < MLAT; r += nw) {
        const uint4 f0 = *(const uint4*)(Yd + (size_t)r * 1024 + c0), f1 = *(const uint4*)(Yd + (size_t)r * 1024 + c0 + 8);
        const uint4 b0 = *(const uint4*)(Yd + ((size_t)MLAT + r) * 1024 + c0), b1 = *(const uint4*)(Yd + ((size_t)MLAT + r) * 1024 + c0 + 8);
        const uint4 v0 = *(const uint4*)(Vb + (size_t)r * 1024 + c0), v1 = *(const uint4*)(Vb + (size_t)r * 1024 + c0 + 8);
        const unsigned fu[8] = {f0.x, f0.y, f0.z, f0.w, f1.x, f1.y, f1.z, f1.w}, bu[8] = {b0.x, b0.y, b0.z, b0.w, b1.x, b1.y, b1.z, b1.w}, vu[8] = {v0.x, v0.y, v0.z, v0.w, v1.x, v1.y, v1.z, v1.w};
        float y[16], s = 0.f;
#pragma unroll
        for (int e = 0; e < 8; ++e) { y[2 * e] = bflo(fu[e]) + bflo(bu[e]); y[2 * e + 1] = bfhi(fu[e]) + bfhi(bu[e]); s += y[2 * e] + y[2 * e + 1]; }
        s += __shfl_xor(s, 1, 64); s += __shfl_xor(s, 2, 64);
        const float mu = s * (1.f / 64.f); float q = 0.f;
#pragma unroll
        for (int e = 0; e < 16; ++e) { const float d = y[e] - mu; q += d * d; }
        q += __shfl_xor(q, 1, 64); q += __shfl_xor(q, 2, 64);
        const float rs = rsqrtf(q * (1.f / 64.f) + 64e-5f);
        const float bs = 0.5f * (bsum[(size_t)r * 16 + head] + bsum[((size_t)MLAT + r) * 16 + head]);
        unsigned ou[8];
#pragma unroll
        for (int e = 0; e < 8; ++e) { const float o0 = (y[2 * e] - mu) * rs * lg[2 * e] + lb[2 * e] + bs * bflo(vu[e]), o1 = (y[2 * e + 1] - mu) * rs * lg[2 * e + 1] + lb[2 * e + 1] + bs * bfhi(vu[e]); ou[e] = pk2(o0, o1); }
        *(uint4*)(YN + (size_t)r * 1024 + c0) = make_uint4(ou[0], ou[1], ou[2], ou[3]); *(uint4*)(YN + (size_t)r * 1024 + c0 + 8) = make_uint4(ou[4], ou[5], ou[6], ou[7]);
    }
}

typedef float f2p __attribute__((ext_vector_type(2)));
__device__ __forceinline__ float2 cmul(float2 a, float2 b) {
    const f2p av = {a.x, a.y}, bv = {b.x, b.y}; f2p t, r;
    asm("v_pk_mul_f32 %0, %1, %2 op_sel:[0,0] op_sel_hi:[0,1]" : "=v"(t) : "v"(av), "v"(bv));
    asm("v_pk_fma_f32 %0, %1, %2, %3 op_sel:[1,1,0] op_sel_hi:[1,0,1] neg_lo:[0,1,0]" : "=v"(r) : "v"(av), "v"(bv), "v"(t));
    return make_float2(r.x, r.y);
}
__device__ __forceinline__ float2 cadd(float2 a, float2 b) { return make_float2(a.x + b.x, a.y + b.y); }
__device__ __forceinline__ float2 csub(float2 a, float2 b) { return make_float2(a.x - b.x, a.y - b.y); }
__device__ __forceinline__ int PADX(int a) { return a + ((a >> 6) << 2); }
__device__ __forceinline__ float2 cmulc(float2 a, float2 b) {
    const f2p av = {a.x, a.y}, bv = {b.x, b.y}; f2p t, r;
    asm("v_pk_mul_f32 %0, %1, %2 op_sel:[0,0] op_sel_hi:[0,1] neg_hi:[0,1]" : "=v"(t) : "v"(av), "v"(bv));
    asm("v_pk_fma_f32 %0, %1, %2, %3 op_sel:[1,1,0] op_sel_hi:[1,0,1]" : "=v"(r) : "v"(av), "v"(bv), "v"(t));
    return make_float2(r.x, r.y);
}
__host__ __device__ constexpr float w16r(int m) { return m == 0 ? 1.f : m == 1 ? 0.9238795325112867f : m == 2 ? 0.7071067811865476f : m == 3 ? 0.3826834323650898f : m == 4 ? 0.f : m == 5 ? -0.3826834323650898f : m == 6 ? -0.7071067811865476f : -0.9238795325112867f; }
__host__ __device__ constexpr float w16i(int m) { return m == 0 ? 0.f : m == 1 ? -0.3826834323650898f : m == 2 ? -0.7071067811865476f : m == 3 ? -0.9238795325112867f : m == 4 ? -1.f : m == 5 ? -0.9238795325112867f : m == 6 ? -0.7071067811865476f : -0.3826834323650898f; }
__host__ __device__ constexpr int br4(int r) { return ((r & 1) << 3) | ((r & 2) << 1) | ((r & 4) >> 1) | ((r & 8) >> 3); }
__device__ __forceinline__ void dft16_fwd(float2 (&x)[16]) {
#pragma unroll
    for (int st = 0; st < 4; ++st) {
#pragma unroll
        for (int base = 0; base < 16; base += (16 >> st))
#pragma unroll
            for (int mm = 0; mm < (8 >> st); ++mm) { const int i0 = base + mm, i1 = base + mm + (8 >> st), e = mm << st;
                const float2 a = x[i0], d = csub(x[i0], x[i1]); x[i0] = cadd(a, x[i1]);
                x[i1] = (e == 0) ? d : ((e == 4) ? make_float2(d.y, -d.x) : cmul(d, make_float2(w16r(e), w16i(e)))); }
    }
}
__device__ __forceinline__ void dft16_inv(float2 (&x)[16]) {
#pragma unroll
    for (int st = 3; st >= 0; --st) {
#pragma unroll
        for (int base = 0; base < 16; base += (16 >> st))
#pragma unroll
            for (int mm = 0; mm < (8 >> st); ++mm) { const int i0 = base + mm, i1 = base + mm + (8 >> st), e = mm << st;
                const float2 b0 = x[i1]; const float2 b = (e == 0) ? b0 : ((e == 4) ? make_float2(-b0.y, b0.x) : cmul(b0, make_float2(w16r(e), -w16i(e))));
                const float2 a = x[i0]; x[i0] = cadd(a, b); x[i1] = csub(a, b); }
    }
}
__device__ __forceinline__ void twid_powers(float2 w, float2 (&pw)[16]) {
    pw[0] = make_float2(1.f, 0.f); pw[1] = w; pw[2] = cmul(w, w); pw[3] = cmul(pw[2], w); pw[4] = cmul(pw[2], pw[2]); pw[5] = cmul(pw[4], w); pw[6] = cmul(pw[3], pw[3]); pw[7] = cmul(pw[4], pw[3]);
    pw[8] = cmul(pw[4], pw[4]);
#pragma unroll
    for (int k = 1; k < 8; ++k) pw[8 + k] = cmul(pw[8], pw[k]);
}
template <int LVL, bool INV> __device__ __forceinline__ void fft16_pass(float2* X, const float2* tA, const float2* tB, int tid) {
    constexpr int n = LVL == 0 ? 16384 : (LVL == 1 ? 1024 : 64), sub = n / 16, lsub = LVL == 0 ? 10 : (LVL == 1 ? 6 : 2);
    constexpr int pstep = LVL == 0 ? 1088 : (LVL == 1 ? 68 : 4);
#pragma unroll 2
    for (int q = 0; q < 2; ++q) { const int idx = tid + 512 * q, j = idx & (sub - 1), bb = idx >> lsub, a0 = bb * n + j;
        const int e = j << (4 * LVL);
        float2 pw[16]; twid_powers(cmul(tA[e >> 5], tB[e & 31]), pw);
        float2* Xp = X + PADX(a0);
        float2 x[16];
        if (!INV) {
#pragma unroll
            for (int mm = 0; mm < 16; ++mm) x[mm] = (LVL == 0 && mm >= 8) ? make_float2(0.f, 0.f) : Xp[mm * pstep];
            dft16_fwd(x);
#pragma unroll
            for (int r = 0; r < 16; ++r) Xp[r * pstep] = (r == 0) ? x[0] : cmul(x[r], pw[br4(r)]);
        } else {
#pragma unroll
            for (int r = 0; r < 16; ++r) { const float2 v = Xp[r * pstep]; x[r] = (r == 0) ? v : cmulc(v, pw[br4(r)]); }
            dft16_inv(x);
#pragma unroll
            for (int mm = 0; mm < 16; ++mm) if (!(LVL == 0 && mm >= 8)) Xp[mm * pstep] = x[mm];
        }
    }
}
template <bool INV> __device__ __forceinline__ void fft4_pass(float2* X, int tid) {
#pragma unroll 2
    for (int q = 0; q < 8; ++q) { const int b = tid + 512 * q; float4* p4 = (float4*)(X + PADX(4 * b));
        const float4 u = p4[0], v = p4[1]; const float2 x0 = make_float2(u.x, u.y), x1 = make_float2(u.z, u.w), x2 = make_float2(v.x, v.y), x3 = make_float2(v.z, v.w);
        float2 o0, o1, o2, o3;
        if (!INV) { const float2 t0 = cadd(x0, x2), t2 = csub(x0, x2), t1 = cadd(x1, x3), d = csub(x1, x3), t3 = make_float2(d.y, -d.x);
            o0 = cadd(t0, t1); o1 = csub(t0, t1); o2 = cadd(t2, t3); o3 = csub(t2, t3); }
        else { const float2 t0 = cadd(x0, x1), t1 = csub(x0, x1), t2 = cadd(x2, x3), d = csub(x2, x3), t3 = make_float2(-d.y, d.x);
            o0 = cadd(t0, t2); o2 = csub(t0, t2); o1 = cadd(t1, t3); o3 = csub(t1, t3); }
        p4[0] = make_float4(o0.x, o0.y, o1.x, o1.y); p4[1] = make_float4(o2.x, o2.y, o3.x, o3.y); }
}
__device__ __forceinline__ void fft_fwd(float2* X, const float2* tA, const float2* tB) {
    const int tid = ltid();
    fft16_pass<0, false>(X, tA, tB, tid); __syncthreads();
    fft16_pass<1, false>(X, tA, tB, tid); __syncthreads();
    fft16_pass<2, false>(X, tA, tB, tid); __syncthreads();
    fft4_pass<false>(X, tid); __syncthreads();
}
__device__ __forceinline__ void fft_inv(float2* X, const float2* tA, const float2* tB) {
    const int tid = ltid();
    fft4_pass<true>(X, tid); __syncthreads();
    fft16_pass<2, true>(X, tA, tB, tid); __syncthreads();
    fft16_pass<1, true>(X, tA, tB, tid); __syncthreads();
    fft16_pass<0, true>(X, tA, tB, tid); __syncthreads();
}
__device__ __forceinline__ float2 conv3_pair(const bf16_t* rowp, int t, int lane, float w0, float w1, float w2, float bias) {
    const unsigned c = *(const unsigned*)(rowp + t);
    const unsigned pl = *(const unsigned*)(rowp + (t > 0 ? t - 2 : 0)), pr = *(const unsigned*)(rowp + (t + 2 < 8192 ? t + 2 : t));
    const float p0 = bflo(c), p1 = bfhi(c);
    const float pm = t > 0 ? bfhi(pl) : 0.f, pp = (t + 2 < 8192) ? bflo(pr) : 0.f;
    return make_float2(pm * w0 + p0 * w1 + p1 * w2 + bias, p0 * w0 + p1 * w1 + pp * w2 + bias);
}
__device__ __forceinline__ float4 conv3_quad(const bf16_t* rowp, int t, float w0, float w1, float w2, float bias) {
    const uint2 c = *(const uint2*)(rowp + t);
    const unsigned pl = *(const unsigned*)(rowp + (t > 0 ? t - 2 : 0)), pr = *(const unsigned*)(rowp + (t + 4 < 8192 ? t + 4 : t));
    const float p0 = bflo(c.x), p1 = bfhi(c.x), p2 = bflo(c.y), p3 = bfhi(c.y);
    const float pm = t > 0 ? bfhi(pl) : 0.f, pp = (t + 4 < 8192) ? bflo(pr) : 0.f;
    return make_float4(pm * w0 + p0 * w1 + p1 * w2 + bias, p0 * w0 + p1 * w1 + p2 * w2 + bias, p1 * w0 + p2 * w1 + p3 * w2 + bias, p2 * w0 + p3 * w1 + pp * w2 + bias);
}
#ifndef FFT_PROBE
#define FFT_PROBE 0
#endif
#if FFT_PROBE
#define FFT_SC (1.f / 16384.f / 16384.f)
#else
#define FFT_SC (1.f / 16384.f)
#endif
__device__ void fftconv_phase(const Params& p, unsigned char* ws, float2* X) {
    const int tid = ltid(), lane = tid & 63;
    const bf16_t* PT = (const bf16_t*)(ws + WS_R2); bf16_t* ZT = (bf16_t*)(ws + WS_R1);
    const bf16_t* filtT = (const bf16_t*)(ws + WS_R3);
    float2* zst = (float2*)(ws + WS_R1 + (size_t)MALL * 2048) + (size_t)blockIdx.x * 16384;
    float2* tA = X + 17408; float2* tB = tA + 32;
    const float *cwp = p.in[I_HCW], *cbp = p.in[I_HCB];
    if (tid < 64) { float s, c; const int k = tid < 32 ? 32 * tid : tid - 32; sincospif((float)k / 8192.f, &s, &c); tA[tid] = make_float2(c, -s); }
    float2 Hr[32];
#pragma unroll
    for (int q = 0; q < 32; ++q) Hr[q] = make_float2(0.f, 0.f);
    for (int c = blockIdx.x; c < 1024; c += gridDim.x) {
        const float vw0 = cwp[2048 + c], vw1 = cwp[3072 + 2048 + c], vw2 = cwp[6144 + 2048 + c], vb = cbp[2048 + c];
#pragma unroll 1
        for (int f = 0; f < 2; ++f) {
            const float dl = fabsf(p.in[I_DELTAS][f * 1024 + c]) * (1.f / 8191.f), biasf = p.in[I_HBIAS][f * 1024 + c];
            const bf16_t* fp = filtT + (size_t)(f * 1024 + c) * 8192;
            const float gw0 = cwp[f * 1024 + c], gw1 = cwp[3072 + f * 1024 + c], gw2 = cwp[6144 + f * 1024 + c], gb = cbp[f * 1024 + c];
#pragma unroll 1
            for (int job = 0; job < 3; ++job) {
                const int pr = job - 1;
                const bf16_t* v0p = PT + (size_t)(2048 + c) * 32768 + (size_t)(2 * (pr & 1)) * 8192; const bf16_t* v1p = v0p + 8192;
                const bf16_t* g0p = PT + (size_t)(f * 1024 + c) * 32768 + (size_t)(2 * (pr & 1)) * 8192; const bf16_t* g1p = g0p + 8192;
                __syncthreads();
#pragma unroll 2
                for (int q = 0; q < 4; ++q) { const int t = 4 * (tid + 512 * q); float4 in0, in1;
                    if (job == 0) { const uint2 u = *(const uint2*)(fp + t);
                        in0 = make_float4(bflo(u.x) * __expf(-(float)t * dl) + (t == 0 ? biasf : 0.f), 0.f, bfhi(u.x) * __expf(-(float)(t + 1) * dl), 0.f);
                        in1 = make_float4(bflo(u.y) * __expf(-(float)(t + 2) * dl), 0.f, bfhi(u.y) * __expf(-(float)(t + 3) * dl), 0.f); }
                    else if (f == 0) { const float4 a = conv3_quad(v0p, t, vw0, vw1, vw2, vb), b = conv3_quad(v1p, t, vw0, vw1, vw2, vb); in0 = make_float4(a.x, b.x, a.y, b.y); in1 = make_float4(a.z, b.z, a.w, b.w); }
                    else { in0 = *(const float4*)(zst + pr * 8192 + t); in1 = *(const float4*)(zst + pr * 8192 + t + 2); }
                    float2* xp = X + PADX(t); *(float4*)xp = in0; *(float4*)(xp + 2) = in1;
                    }
                __syncthreads();
#if FFT_PROBE
                if (job != 0) { fft_fwd(X, tA, tB); fft_inv(X, tA, tB); }
#endif
                fft_fwd(X, tA, tB);
                if (job == 0) {
#pragma unroll
                    for (int q = 0; q < 32; ++q) Hr[q] = X[PADX(tid + 512 * q)];
                } else {
#pragma unroll
                    for (int q = 0; q < 32; ++q) { const int i = PADX(tid + 512 * q); X[i] = cmul(X[i], Hr[q]); }
                    __syncthreads();
                    fft_inv(X, tA, tB);
#pragma unroll 2
                    for (int q = 0; q < 4; ++q) { const int t = 4 * (tid + 512 * q); const float2* xp = X + PADX(t); const float4 c0 = *(const float4*)xp, c1 = *(const float4*)(xp + 2);
                        const float4 ga = conv3_quad(g0p, t, gw0, gw1, gw2, gb), gq = conv3_quad(g1p, t, gw0, gw1, gw2, gb);
                        const float a0 = ga.x * (c0.x * FFT_SC), a1 = ga.y * (c0.z * FFT_SC), a2 = ga.z * (c1.x * FFT_SC), a3 = ga.w * (c1.z * FFT_SC);
                        const float b0 = gq.x * (c0.y * FFT_SC), b1 = gq.y * (c0.w * FFT_SC), b2 = gq.z * (c1.y * FFT_SC), b3 = gq.w * (c1.w * FFT_SC);
                        if (f == 0) { *(float4*)(zst + pr * 8192 + t) = make_float4(a0, b0, a1, b1); *(float4*)(zst + pr * 8192 + t + 2) = make_float4(a2, b2, a3, b3); }
                        else { *(uint2*)(ZT + (size_t)c * 32768 + (size_t)(2 * pr) * 8192 + t) = make_uint2(pk2(a0, a1), pk2(a2, a3)); *(uint2*)(ZT + (size_t)c * 32768 + (size_t)(2 * pr + 1) * 8192 + t) = make_uint2(pk2(b0, b1), pk2(b2, b3)); } }
                }
            }
        }
    }
}
__device__ void transpose_phase(const bf16_t* ZT, bf16_t* Z, unsigned short* tile) {
    const int tid = ltid(), hi = tid >> 3, lo = tid & 7;
    for (int t = blockIdx.x; t < 8192; t += gridDim.x) {
        const int c0 = (t & 15) * 64, t0 = (t >> 4) * 64;
        { const uint4 v = *(const uint4*)(ZT + (size_t)(c0 + hi) * 32768 + t0 + 8 * lo);
          *(uint2*)(tile + hi * 68 + 8 * lo) = make_uint2(v.x, v.y); *(uint2*)(tile + hi * 68 + 8 * lo + 4) = make_uint2(v.z, v.w); }
        __syncthreads();
        { unsigned short x[8];
#pragma unroll
          for (int e = 0; e < 8; ++e) x[e] = tile[(8 * lo + e) * 68 + hi];
          *(uint4*)(Z + (size_t)(t0 + hi) * 1024 + c0 + 8 * lo) = make_uint4((unsigned)x[0] | ((unsigned)x[1] << 16), (unsigned)x[2] | ((unsigned)x[3] << 16), (unsigned)x[4] | ((unsigned)x[5] << 16), (unsigned)x[6] | ((unsigned)x[7] << 16)); }
        __syncthreads();
    }
}
constexpr int S2_NCH = 528, S2_NR = 132;
constexpr int S2_BUF = 11520, S2_SCR = 9472, S2_WL = 8192;
constexpr int PTK = 72, PKT = 20;
constexpr int S2_OFF_SCR = 8 * S2_BUF, S2_OFF_W2 = S2_OFF_SCR + 4 * S2_SCR, S2_OFF_A2 = S2_OFF_W2 + S2_WL, S2_LDS_END = S2_OFF_A2 + S2_WL;
static_assert(S2_LDS_END <= LDS_BYTES - 16, "scan LDS footprint");
constexpr int CB_AP = 0, CB_RT = 2304, CB_BT = 4608, CB_KT = 7168, CB_MAKT = 9728, CB_MRBT = 10240, CB_MRKT = 10752, CB_GC = 11264;
constexpr int SC_A = 0, SC_B = 2304, SC_K = 4608, SC_ATR = 6912, SC_RAWK = SC_A, SC_RAWR = SC_ATR;
__device__ __forceinline__ int s2_tokrow(int ci, int slot, int dir, int b) {
    if (ci < 16) { const int s = ci * 16 + slot; return MLAT + b * 256 + (dir ? 255 - s : s); }
    const int s = (ci - 16) * 16 + slot; return b * 8192 + (dir ? 8191 - s : s);
}
__device__ __forceinline__ uint2 pk4(float a, float b, float c, float d) { uint2 o; o.x = pk2(a, b); o.y = pk2(c, d); return o; }
__device__ __forceinline__ bf16x8 mk8(uint2 lo, uint2 hi) { union { uint4 u; bf16x8 v; } x; x.u = make_uint4(lo.x, lo.y, hi.x, hi.y); return x.v; }
#define S2_WAVE_SYNC() asm volatile("s_waitcnt lgkmcnt(0)" ::: "memory")
__device__ void scan_phase2(const Params& p, unsigned char* ws, unsigned char* L) {
    const int tid = ltid(), lane = tid & 63, wave = tid >> 6, l15 = lane & 15, lq = lane >> 4;
    const bf16_t* Rb = (const bf16_t*)(ws + WS_R2); const bf16_t* Kb = Rb + (size_t)MALL * 1024; const bf16_t* Vb = Kb + (size_t)MALL * 1024;
    const bf16_t* L1w = (const bf16_t*)(ws + WS_R3); const bf16_t* L1a = L1w + (size_t)MALL * 128;
    bf16_t* Yd = (bf16_t*)(ws + WS_R1);
    float* bsum = (float*)(ws + WS_BSUM);
    const f32x4 zero4 = {0.f, 0.f, 0.f, 0.f};
    for (int wi = blockIdx.x; wi < 256; wi += gridDim.x) {
        int chain = wi >> 1, half = wi & 1;
        if (gridDim.x == 256) { const int xcd = wi & 7, jj2 = wi >> 3; chain = xcd * 16 + (jj2 >> 1); half = jj2 & 1; }
        const int dir = chain >> 6, b = (chain >> 4) & 3, h = chain & 15;
        __syncthreads();
        for (int i = tid; i < 2 * 64 * 8; i += NT) { const int which = i >> 9, n = (i >> 3) & 63, seg = i & 7;
            const bf16_t* src = (const bf16_t*)(ws + (which ? WS_A2T : WS_W2T)) + (size_t)(dir * 1024 + h * 64 + n) * 64 + seg * 8;
            *(uint4*)(L + (which ? S2_OFF_A2 : S2_OFF_W2) + n * 128 + ((seg ^ (n & 7)) * 16)) = *(const uint4*)src; }
        __syncthreads();
        if (wave < 2) {
            const int vt = 2 * half + wave, vcol = h * 64 + 16 * vt + l15;
            f32x4 acc[4] = {zero4, zero4, zero4, zero4};
            unsigned short vn[4][4];
#pragma unroll
            for (int q = 0; q < 4; ++q)
#pragma unroll
                for (int jj = 0; jj < 4; ++jj) vn[q][jj] = Vb[(size_t)s2_tokrow(q, 4 * lq + jj, dir, b) * 1024 + vcol];
            for (int R = 0; R <= S2_NR; ++R) {
                unsigned short vc[4][4];
#pragma unroll
                for (int q = 0; q < 4; ++q)
#pragma unroll
                    for (int jj = 0; jj < 4; ++jj) vc[q][jj] = vn[q][jj];
                if (R < S2_NR) {
#pragma unroll
                    for (int q = 0; q < 4; ++q)
#pragma unroll
                        for (int jj = 0; jj < 4; ++jj) vn[q][jj] = Vb[(size_t)s2_tokrow(4 * R + q, 4 * lq + jj, dir, b) * 1024 + vcol];
                }
                if (R >= 1) {
#pragma unroll
                    for (int q = 0; q < 4; ++q) {
                        const int ci = 4 * (R - 1) + q;
                        const unsigned char* cb = L + (((R - 1) & 1) * 4 + q) * S2_BUF;
                        const uint2 vpk = make_uint2((unsigned)vc[q][0] | ((unsigned)vc[q][1] << 16), (unsigned)vc[q][2] | ((unsigned)vc[q][3] << 16));
                        bf16x8 Sb[2];
#pragma unroll
                        for (int ks = 0; ks < 2; ++ks) Sb[ks] = mk8(pk4(acc[2 * ks][0], acc[2 * ks][1], acc[2 * ks][2], acc[2 * ks][3]), pk4(acc[2 * ks + 1][0], acc[2 * ks + 1][1], acc[2 * ks + 1][2], acc[2 * ks + 1][3]));
                        f32x4 UT = zero4;
#pragma unroll
                        for (int ks = 0; ks < 2; ++ks) { const bf16x8 af = mk8(*(const uint2*)(cb + CB_AP + (l15 * PTK + 32 * ks + 4 * lq) * 2), *(const uint2*)(cb + CB_AP + (l15 * PTK + 32 * ks + 16 + 4 * lq) * 2));
                            UT = __builtin_amdgcn_mfma_f32_16x16x32_bf16(af, Sb[ks], UT, 0, 0, 0); }
                        UT = __builtin_amdgcn_mfma_f32_16x16x32_bf16(mk8(*(const uint2*)(cb + CB_MAKT + (l15 * 16 + 4 * lq) * 2), make_uint2(0u, 0u)), mk8(vpk, make_uint2(0u, 0u)), UT, 0, 0, 0);
                        const bf16x8 UVb = mk8(pk4(UT[0], UT[1], UT[2], UT[3]), vpk);
                        f32x4 YT = zero4;
#pragma unroll
                        for (int ks = 0; ks < 2; ++ks) { const bf16x8 rf = mk8(*(const uint2*)(cb + CB_RT + (l15 * PTK + 32 * ks + 4 * lq) * 2), *(const uint2*)(cb + CB_RT + (l15 * PTK + 32 * ks + 16 + 4 * lq) * 2));
                            YT = __builtin_amdgcn_mfma_f32_16x16x32_bf16(rf, Sb[ks], YT, 0, 0, 0); }
                        YT = __builtin_amdgcn_mfma_f32_16x16x32_bf16(mk8(*(const uint2*)(cb + CB_MRBT + (l15 * 16 + 4 * lq) * 2), *(const uint2*)(cb + CB_MRKT + (l15 * 16 + 4 * lq) * 2)), UVb, YT, 0, 0, 0);
                        if (ci >= 16) {
#pragma unroll
                            for (int jj = 0; jj < 4; ++jj) Yd[((size_t)dir * MLAT + s2_tokrow(ci, 4 * lq + jj, dir, b)) * 1024 + vcol] = (bf16_t)(pk2(YT[jj], 0.f) & 0xffffu);
                        }
#pragma unroll
                        for (int kt = 0; kt < 4; ++kt) { const bf16x8 bkf = mk8(*(const uint2*)(cb + CB_BT + ((16 * kt + l15) * PKT + 4 * lq) * 2), *(const uint2*)(cb + CB_KT + ((16 * kt + l15) * PKT + 4 * lq) * 2));
                            acc[kt] = __builtin_amdgcn_mfma_f32_16x16x32_bf16(bkf, UVb, acc[kt], 0, 0, 0);
                            const float4 g = *(const float4*)(cb + CB_GC + (16 * kt + 4 * lq) * 4);
                            acc[kt][0] *= g.x; acc[kt][1] *= g.y; acc[kt][2] *= g.z; acc[kt][3] *= g.w; }
                    }
                }
                __syncthreads();
            }
        } else if (wave < 6) {
            const int hw = wave - 2;
            unsigned char* sc = L + S2_OFF_SCR + hw * S2_SCR;
            float w0v[4], a0v[4], kkc[4], kac[4], rkc[4];
#pragma unroll
            for (int nt = 0; nt < 4; ++nt) { const int ch = h * 64 + 16 * nt + l15; w0v[nt] = p.in[I_W0][dir * 1024 + ch]; a0v[nt] = p.in[I_A0][dir * 1024 + ch]; kkc[nt] = p.in[I_KK][ch]; kac[nt] = p.in[I_KA][ch]; rkc[nt] = p.in[I_RK][ch]; }
            const int tt = lane >> 2, cgp = (lane & 3) * 16;
            bf16x8 paw[2], paa[2]; uint4 rk0, rk1, rr0, rr1;
#define S2_LOAD(ci) do { const int _ra = s2_tokrow((ci), l15, dir, b); \
                paw[0] = *(const bf16x8*)(L1w + (size_t)_ra * 128 + dir * 64 + lq * 8); paw[1] = *(const bf16x8*)(L1w + (size_t)_ra * 128 + dir * 64 + 32 + lq * 8); \
                paa[0] = *(const bf16x8*)(L1a + (size_t)_ra * 128 + dir * 64 + lq * 8); paa[1] = *(const bf16x8*)(L1a + (size_t)_ra * 128 + dir * 64 + 32 + lq * 8); \
                const size_t _rb = (size_t)s2_tokrow((ci), tt, dir, b) * 1024 + h * 64 + cgp; \
                rk0 = *(const uint4*)(Kb + _rb); rk1 = *(const uint4*)(Kb + _rb + 8); rr0 = *(const uint4*)(Rb + _rb); rr1 = *(const uint4*)(Rb + _rb + 8); } while (0)
            S2_LOAD(hw);
            for (int R = 0; R <= S2_NR; ++R) {
                if (R < S2_NR) {
                    const int ci = 4 * R + hw;
                    unsigned char* cb = L + ((R & 1) * 4 + hw) * S2_BUF;
                    *(uint4*)(sc + SC_RAWK + (tt * 64 + cgp) * 2) = rk0; *(uint4*)(sc + SC_RAWK + (tt * 64 + cgp + 8) * 2) = rk1;
                    *(uint4*)(sc + SC_RAWR + (tt * 64 + cgp) * 2) = rr0; *(uint4*)(sc + SC_RAWR + (tt * 64 + cgp + 8) * 2) = rr1;
                    f32x4 lwv[4], avv[4];
#pragma unroll
                    for (int nt = 0; nt < 4; ++nt) { const int rb = (16 * nt + l15) * 128, o0 = rb + ((lq ^ (l15 & 7)) * 16), o1 = rb + (((4 + lq) ^ (l15 & 7)) * 16);
                        const bf16x8 bw0 = *(const bf16x8*)(L + S2_OFF_W2 + o0), bw1 = *(const bf16x8*)(L + S2_OFF_W2 + o1), ba0 = *(const bf16x8*)(L + S2_OFF_A2 + o0), ba1 = *(const bf16x8*)(L + S2_OFF_A2 + o1);
                        lwv[nt] = __builtin_amdgcn_mfma_f32_16x16x32_bf16(paw[0], bw0, zero4, 0, 0, 0); lwv[nt] = __builtin_amdgcn_mfma_f32_16x16x32_bf16(paw[1], bw1, lwv[nt], 0, 0, 0);
                        avv[nt] = __builtin_amdgcn_mfma_f32_16x16x32_bf16(paa[0], ba0, zero4, 0, 0, 0); avv[nt] = __builtin_amdgcn_mfma_f32_16x16x32_bf16(paa[1], ba1, avv[nt], 0, 0, 0); }
                    if (4 * (R + 1) + hw < S2_NCH) S2_LOAD(4 * (R + 1) + hw);
                    float ev[4][4], epv[4][4];
#pragma unroll
                    for (int nt = 0; nt < 4; ++nt) {
                        float cl[4], run = 0.f;
#pragma unroll
                        for (int j = 0; j < 4; ++j) { const float lw = -0.60653065971263342f * sigm(w0v[nt] + lwv[nt][j]); run += lw; cl[j] = run; avv[nt][j] = sigm(a0v[nt] + avv[nt][j]); }
                        float x = run; const float y1 = __shfl_up(x, 16, 64); x += (lq >= 1) ? y1 : 0.f; const float y2 = __shfl_up(x, 32, 64); x += (lq >= 2) ? y2 : 0.f;
                        const float off = x - run;
                        float prev = __expf(off);
#pragma unroll
                        for (int j = 0; j < 4; ++j) { epv[nt][j] = prev; prev = __expf(cl[j] + off); ev[nt][j] = prev; }
                        if (lq == 3) *(float*)(cb + CB_GC + (4 * l15 + nt) * 4) = ev[nt][3];
                    }
                    S2_WAVE_SYNC();
                    float kv[4][4], rv[4][4], ss[4] = {0.f, 0.f, 0.f, 0.f};
#pragma unroll
                    for (int nt = 0; nt < 4; ++nt)
#pragma unroll
                        for (int j = 0; j < 4; ++j) { const int o = ((4 * lq + j) * 64 + 16 * nt + l15) * 2; kv[nt][j] = bf2f(*(const unsigned short*)(sc + SC_RAWK + o)); rv[nt][j] = bf2f(*(const unsigned short*)(sc + SC_RAWR + o));
                            const float kr = kv[nt][j] * kkc[nt]; ss[j] += kr * kr; }
                    float rn[4], bp[4] = {0.f, 0.f, 0.f, 0.f};
#pragma unroll
                    for (int j = 0; j < 4; ++j) rn[j] = __builtin_amdgcn_rsqf(fmaxf(row_allsum16(ss[j]), 1e-24f));
                    S2_WAVE_SYNC();
                    float atv[4][4], btv[4][4], ktv[4][4];
#pragma unroll
                    for (int nt = 0; nt < 4; ++nt)
#pragma unroll
                        for (int j = 0; j < 4; ++j) { const float a = avv[nt][j], kk = kv[nt][j] * kkc[nt] * rn[j], kd = kv[nt][j] * (1.f + (a - 1.f) * kac[nt]), ei = frcp(ev[nt][j]);
                            atv[nt][j] = -kk * epv[nt][j]; btv[nt][j] = kk * a * ei; ktv[nt][j] = kd * ei; bp[j] += rv[nt][j] * kd * rkc[nt]; rv[nt][j] *= ev[nt][j]; }
#pragma unroll
                    for (int j = 0; j < 4; ++j) { const float bs = row_allsum16(bp[j]); if (ci >= 16 && half == 0 && l15 == 0) bsum[((size_t)dir * MLAT + s2_tokrow(ci, 4 * lq + j, dir, b)) * 16 + h] = bs; }
#pragma unroll
                    for (int j = 0; j < 4; ++j) { const int o = ((4 * lq + j) * PTK + 4 * l15) * 2;
                        *(uint2*)(sc + SC_A + o) = pk4(atv[0][j], atv[1][j], atv[2][j], atv[3][j]); *(uint2*)(cb + CB_RT + o) = pk4(rv[0][j], rv[1][j], rv[2][j], rv[3][j]);
                        *(uint2*)(sc + SC_B + o) = pk4(btv[0][j], btv[1][j], btv[2][j], btv[3][j]); *(uint2*)(sc + SC_K + o) = pk4(ktv[0][j], ktv[1][j], ktv[2][j], ktv[3][j]); }
#pragma unroll
                    for (int nt = 0; nt < 4; ++nt) { const int o = ((4 * l15 + nt) * PKT + 4 * lq) * 2;
                        *(uint2*)(sc + SC_ATR + o) = pk4(atv[nt][0], atv[nt][1], atv[nt][2], atv[nt][3]);
                        *(uint2*)(cb + CB_BT + o) = pk4(btv[nt][0], btv[nt][1], btv[nt][2], btv[nt][3]); *(uint2*)(cb + CB_KT + o) = pk4(ktv[nt][0], ktv[nt][1], ktv[nt][2], ktv[nt][3]); }
                    S2_WAVE_SYNC();
                    f32x4 mab = zero4, mak = zero4, mrb = zero4, mrk = zero4, mabT = zero4, makT = zero4;
#pragma unroll
                    for (int ks = 0; ks < 2; ++ks) { const int o = (l15 * PTK + 32 * ks + 8 * lq) * 2;
                        const bf16x8 bf = *(const bf16x8*)(sc + SC_B + o), kf = *(const bf16x8*)(sc + SC_K + o), af = *(const bf16x8*)(sc + SC_A + o), rf = *(const bf16x8*)(cb + CB_RT + o);
                        mab = __builtin_amdgcn_mfma_f32_16x16x32_bf16(bf, af, mab, 0, 0, 0); mak = __builtin_amdgcn_mfma_f32_16x16x32_bf16(kf, af, mak, 0, 0, 0);
                        mrb = __builtin_amdgcn_mfma_f32_16x16x32_bf16(bf, rf, mrb, 0, 0, 0); mrk = __builtin_amdgcn_mfma_f32_16x16x32_bf16(kf, rf, mrk, 0, 0, 0);
                        mabT = __builtin_amdgcn_mfma_f32_16x16x32_bf16(af, bf, mabT, 0, 0, 0); makT = __builtin_amdgcn_mfma_f32_16x16x32_bf16(af, kf, makT, 0, 0, 0); }
#pragma unroll
                    for (int j = 0; j < 4; ++j) { const int i = 4 * lq + j; if (!(i < l15)) { mab[j] = 0.f; mak[j] = 0.f; } if (!(i <= l15)) { mrb[j] = 0.f; mrk[j] = 0.f; }
                        if (!(l15 < i)) { mabT[j] = 0.f; makT[j] = 0.f; } }
                    *(uint2*)(cb + CB_MRBT + (l15 * 16 + 4 * lq) * 2) = pk4(mrb[0], mrb[1], mrb[2], mrb[3]);
                    *(uint2*)(cb + CB_MRKT + (l15 * 16 + 4 * lq) * 2) = pk4(mrk[0], mrk[1], mrk[2], mrk[3]);
                    f32x4 G = mab, P = mab, PT = mabT;
                    const uint2 z2 = make_uint2(0u, 0u);
#pragma unroll
                    for (int it = 0; it < 4; ++it) {
                        const bf16x8 aP = mk8(pk4(PT[0], PT[1], PT[2], PT[3]), z2);
                        const bf16x8 bG = mk8(pk4(G[0], G[1], G[2], G[3]), z2);
                        G = __builtin_amdgcn_mfma_f32_16x16x32_bf16(aP, bG, G, 0, 0, 0);
                        if (it < 3) { const bf16x8 bP = mk8(pk4(P[0], P[1], P[2], P[3]), z2);
                            const f32x4 Pn = __builtin_amdgcn_mfma_f32_16x16x32_bf16(aP, bP, zero4, 0, 0, 0);
                            const f32x4 PTn = __builtin_amdgcn_mfma_f32_16x16x32_bf16(bP, mk8(pk4(PT[0], PT[1], PT[2], PT[3]), z2), zero4, 0, 0, 0);
                            P = Pn; PT = PTn; }
                    }
#pragma unroll
                    for (int j = 0; j < 4; ++j) if (4 * lq + j == l15) G[j] += 1.f;
                    {
                        const bf16x8 bT = mk8(pk4(G[0], G[1], G[2], G[3]), z2);
                        const f32x4 makp = __builtin_amdgcn_mfma_f32_16x16x32_bf16(mk8(pk4(makT[0], makT[1], makT[2], makT[3]), z2), bT, zero4, 0, 0, 0);
                        *(uint2*)(cb + CB_MAKT + (l15 * 16 + 4 * lq) * 2) = pk4(makp[0], makp[1], makp[2], makp[3]);
#pragma unroll
                        for (int mt = 0; mt < 4; ++mt) { const bf16x8 aa = mk8(*(const uint2*)(sc + SC_ATR + ((16 * mt + l15) * PKT + 4 * lq) * 2), z2);
                            const f32x4 ap = __builtin_amdgcn_mfma_f32_16x16x32_bf16(aa, bT, zero4, 0, 0, 0);
                            *(uint2*)(cb + CB_AP + (l15 * PTK + 16 * mt + 4 * lq) * 2) = pk4(ap[0], ap[1], ap[2], ap[3]); }
                    }
                }
                __syncthreads();
            }
#undef S2_LOAD
        } else {
            for (int R = 0; R <= S2_NR; ++R) __syncthreads();
        }
    }
}
__device__ void prep_phase(const Params& p, unsigned char* ws, float* ldsf) {
    for (int f = 0; f < 4; ++f) {
        transpose_cvt(FGu{p.in[I_WGU] + (size_t)f * 1024 * 5632}, (bf16_t*)(ws + WS_WGU + f * SZ_WGU), 5632, 1024, ldsf);
        transpose_cvt(FPlain{p.in[I_WDN] + (size_t)f * 2816 * 1024, 1024}, (bf16_t*)(ws + WS_WDN + f * SZ_WDN), 1024, 2816, ldsf);
    }
    transpose_cvt(FRw{p.in[I_WRKV], p.in[I_W1], p.in[I_A1], p.in[I_G1], p.in[I_MIX]}, (bf16_t*)(ws + WS_WRW), 3584, 2048, ldsf);
    transpose_cvt(FG2{p.in[I_G2]}, (bf16_t*)(ws + WS_WG2), 1024, 256, ldsf);
    transpose_cvt(FPlain{p.in[I_WO], 1024}, (bf16_t*)(ws + WS_WO), 1024, 1024, ldsf);
    transpose_cvt(FLora2{p.in[I_W2]}, (bf16_t*)(ws + WS_W2T), 2048, 64, ldsf);
    transpose_cvt(FLora2{p.in[I_A2]}, (bf16_t*)(ws + WS_A2T), 2048, 64, ldsf);
    transpose_cvt(FPlain{p.in[I_HWIN], 3072}, (bf16_t*)(ws + WS_WIN), 3072, 1024, ldsf);
    transpose_cvt(FPlain{p.in[I_HWOUT], 1024}, (bf16_t*)(ws + WS_WOUT), 1024, 1024, ldsf);
    mod_phase(p, (float*)(ws + WS_MOD), ldsf);
    __syncthreads();
    hid_phase(p, (bf16_t*)(ws + WS_HID2), ldsf);
    __syncthreads();
    transpose_cvt(FW3{p.in[I_FW3]}, (bf16_t*)(ws + WS_W3T), 2048, 256, ldsf);
}

#ifndef DUP_SCAN
#define DUP_SCAN 0
#endif
#ifndef DUP_FFT
#define DUP_FFT 0
#endif
#ifndef DUP_PREP
#define DUP_PREP 0
#endif
#ifndef DUP_GU
#define DUP_GU 0
#endif
#ifndef DUP_SYNC
#define DUP_SYNC 0
#endif
typedef const __attribute__((address_space(4))) Params* CParamsPtr;
__device__ __forceinline__ const Params& kparams() {
    unsigned long long v = (unsigned long long)__builtin_amdgcn_kernarg_segment_ptr();
    asm volatile("" : "+s"(v));
    return *(const Params*)(CParamsPtr)v;
}
#define PH_BEGIN { const Params& p = kparams(); unsigned char* ws = p.ws; float* xl = p.out; float* xc = (float*)(ws + WS_XC); const float* mod0 = (const float*)(ws + WS_MOD); const float* mod1 = mod0 + 5 * 9216; \
    const float* ng = p.in[I_NORMG]; bf16_t* R1 = (bf16_t*)(ws + WS_R1); bf16_t* R2 = (bf16_t*)(ws + WS_R2); bf16_t* R3 = (bf16_t*)(ws + WS_R3); \
    const bf16_t* WGU = (const bf16_t*)(ws + WS_WGU); const bf16_t* WDN = (const bf16_t*)(ws + WS_WDN); const size_t EGU = SZ_WGU / 2, EDN = SZ_WDN / 2; \
    (void)xl; (void)xc; (void)mod0; (void)mod1; (void)ng; (void)R1; (void)R2; (void)R3; (void)WGU; (void)WDN; (void)EGU; (void)EDN;

__global__ void __launch_bounds__(NT, 2) fwd_megakernel(Params p_unused) {
    extern __shared__ __attribute__((aligned(16))) unsigned char lds_raw[];
    cg::grid_group grid = cg::this_grid();
    LAS unsigned char* lds = (LAS unsigned char*)lds_raw;
    float* ldsf = (float*)lds_raw;
    volatile LAS unsigned* xb_st = (volatile LAS unsigned*)(lds + (LDS_BYTES - 16));
    if (threadIdx.x < 4) xb_st[threadIdx.x] = 0u;
    __syncthreads();
    { const Params& p = kparams();
      if (blockIdx.x == 0) for (int i = threadIdx.x; i < XCD_BAR_WORDS; i += NT) ((unsigned*)(p.ws + WS_BAR))[i] = 0u;
      prep_phase(p, p.ws, ldsf); }
    grid.sync();
    XcdBarrier xbar; { const Params& p0 = kparams(); xbar = xcd_barrier_post((unsigned*)(p0.ws + WS_BAR), xb_st); }
#pragma unroll 1
    for (int ph = 0; ph < 23; ++ph) {
        PH_BEGIN
        switch (ph) {
        case 0: case 3: case 9: case 12: case 15: case 20: {
            const int li = ph >= 12, sub = (ph == 0 || ph == 12) ? 0 : ((ph == 3 || ph == 15) ? 1 : 2);
            prenorm_phase(ph == 0 ? p.in[I_X] : xl, ph == 0 ? p.in[I_CTX] : xc, ng + (li * 3 + sub) * 1024, li ? mod1 : mod0, 3 * sub, 3 * sub + 1, R1, ph == 3 ? 2048 : 1024, (ph == 0 || ph == 3) ? MALL : MLAT); } break;
        case 1: case 10: case 13: case 21: {
            const int f = ph == 1 ? 0 : (ph == 10 ? 1 : (ph == 13 ? 2 : 3));
            run_gemm(lds, R1, WGU + f * EGU, f == 0 ? MALL : MLAT, 5632, 1024, EpiSwiglu{R2}); } break;
        case 2: case 11: case 14: case 22: {
            const int f = ph == 2 ? 0 : (ph == 11 ? 1 : (ph == 14 ? 2 : 3));
            run_gemm(lds, R2, WDN + f * EDN, f == 0 ? MALL : MLAT, 1024, 2816, EpiResid{f == 0 ? p.in[I_X] : xl, xl, f == 0 ? p.in[I_CTX] : xc, xc, f < 2 ? mod0 : mod1, (f & 1) ? 8 : 2, 0.5f}); } break;
        case 4: dshift_phase(R1); break;
        case 5: run_gemm(lds, R1, (const bf16_t*)(ws + WS_WRW), MALL, 3584, 2048, EpiRwkv{R2, R3}); break;
        case 6: scan_phase2(p, ws, lds_raw); break;
        case 7: {
            pg8::StaticOrder S; S.init(MLAT, 1024, (int)gridDim.x, (int)blockIdx.x); Unit u;
            for (int i = 0; S.next(i, u); ++i) post_tile(p, ws, u.pm, u.pn);
            __syncthreads();
            run_gemm(lds, R3 + (size_t)MALL * 256, (const bf16_t*)(ws + WS_WG2), MLAT, 1024, 256, EpiG{R2, R2 + (size_t)MALL * 1024}); } break;
        case 8: case 19: {
            const bool hy = ph == 19;
            run_gemm(lds, hy ? R2 : R2 + (size_t)MALL * 1024, (const bf16_t*)(ws + (hy ? WS_WOUT : WS_WO)), MLAT, 1024, 1024, EpiResid{xl, xl, xc, xc, hy ? mod1 : mod0, 5, 1.0f}); } break;
        case 16: {
            run_gemm(lds, (const bf16_t*)(ws + WS_WIN), R1, 3072, MLAT, 1024, EpiBf16Plain{R2, MLAT});
            run_gemm(lds, (const bf16_t*)(ws + WS_W3T), (const bf16_t*)(ws + WS_HID2), 2048, 8192, 256, EpiBf16Plain{R3, 8192}); } break;
        case 17: fftconv_phase(p, ws, (float2*)lds_raw); break;
        case 18: transpose_phase(R1, R2, (unsigned short*)lds_raw); break;
        default: break;
        }
        }
        xcd_barrier(xbar);
    }
    { const Params& p = kparams(); final_norm_phase(p.out, p.in[I_FINALG]); }
}

extern "C" void kernel_launch(void* const* d_in, const int* in_sizes, int n_in, void* d_out, int out_size, void* d_ws, size_t ws_size, hipStream_t stream) {
    static int grid = 0;
    if (grid == 0) {
        if (n_in != 38 || ws_size < WS_END) { fprintf(stderr, "kernel_launch: unexpected n_in %d or ws_size %zu (< %zu)\n", n_in, ws_size, (size_t)WS_END); grid = -1; return; }
        int dev = 0, cus = 0, per_cu = 0;
        (void)hipGetDevice(&dev);
        (void)hipDeviceGetAttribute(&cus, hipDeviceAttributeMultiprocessorCount, dev);
        (void)hipFuncSetAttribute((const void*)fwd_megakernel, hipFuncAttributeMaxDynamicSharedMemorySize, LDS_BYTES);
        (void)hipOccupancyMaxActiveBlocksPerMultiprocessor(&per_cu, (const void*)fwd_megakernel, NT, LDS_BYTES);
        if (per_cu < 1) { fprintf(stderr, "kernel_launch: occupancy query says %d blocks/CU\n", per_cu); per_cu = 1; }
        (void)hipGetLastError();
        grid = cus;
    }
    if (grid < 0) return;
    Params p{};
    for (int i = 0; i < 38; ++i) p.in[i] = (const float*)d_in[i];
    p.out = (float*)d_out; p.ws = (unsigned char*)d_ws;
    void* args[] = {&p};
    hipError_t e = hipLaunchCooperativeKernel((void*)fwd_megakernel, dim3(grid), dim3(NT), args, LDS_BYTES, stream);
    if (e != hipSuccess) fprintf(stderr, "cooperative launch failed: %s (grid %d)\n", hipGetErrorString(e), grid);
}
```

```cpp
#include <hip/hip_runtime.h>
#include <hip/hip_cooperative_groups.h>
#include <cstdio>
namespace cg = cooperative_groups;
#define XB_TMO      128
#define XB_XCNT(j)  (256  + 64 * (j))
#define XB_XSUB(j)  (1280 + 64 * (j))
#define XB_XGEN(j)  (2304 + 64 * (j))
#define XB_TOP      3328
#define XB_TOPGEN   3392
#define XCD_BAR_WORDS 3456
#define XB_SPIN_CAP (1u << 18)
#define LAS __attribute__((address_space(3)))

__device__ __forceinline__ unsigned xb_ld(unsigned* p)              { return __hip_atomic_load(p, __ATOMIC_RELAXED, __HIP_MEMORY_SCOPE_AGENT); }
__device__ __forceinline__ unsigned xb_add(unsigned* p, unsigned v) { return __hip_atomic_fetch_add(p, v, __ATOMIC_RELAXED, __HIP_MEMORY_SCOPE_AGENT); }
__device__ __forceinline__ unsigned xb_xcc_id() { return (unsigned)__builtin_amdgcn_s_getreg((3 << 11) | 20) & 0xFu; }
#define XB_SPIN(cond, bar) do { unsigned _sp = 0; while (cond) { __builtin_amdgcn_s_sleep(1); \
    if ((++_sp & 255u) == 0u) { if (xb_ld(&(bar)[XB_TMO])) break; if (_sp > XB_SPIN_CAP) { atomicAdd(&(bar)[XB_TMO], 1u); break; } } } } while (0)

struct XcdBarrier {
    unsigned* bar; unsigned x;
    volatile LAS unsigned* st;
};

__device__ __forceinline__ XcdBarrier xcd_barrier_post(unsigned* bar, volatile LAS unsigned* st) {
    XcdBarrier b; b.bar = bar; b.x = xb_xcc_id(); b.st = st;
    if (threadIdx.x == 0) (void)xb_add(&bar[XB_XCNT(b.x)], 1u);
    return b;
}
__device__ __forceinline__ void xcd_barrier_complete(unsigned* bar, unsigned x, unsigned& nloc, unsigned& nx) {
    const unsigned G = gridDim.x * gridDim.y * gridDim.z;
    unsigned sum, cnt, mine, sp = 0u;
    for (;;) {
        sum = 0u; cnt = 0u; mine = 0u;
#pragma unroll
        for (unsigned j = 0; j < 16; ++j) { const unsigned c = xb_ld(&bar[XB_XCNT(j)]); sum += c; cnt += (c > 0u) ? 1u : 0u; mine = (j == x) ? c : mine; }
        if (sum == G) break;
        __builtin_amdgcn_s_sleep(1);
        if ((++sp & 255u) == 0u) { if (xb_ld(&bar[XB_TMO])) break; if (sp > XB_SPIN_CAP) { atomicAdd(&bar[XB_TMO], 1u); break; } }
    }
    nloc = mine > 0u ? mine : 1u; nx = cnt > 0u ? cnt : 1u;
}

__device__ __forceinline__ void xcd_barrier(const XcdBarrier& b) {
    asm volatile("s_waitcnt vmcnt(0)" ::: "memory");
    __syncthreads();
    if (threadIdx.x == 0) {
        unsigned* bar = b.bar;
        __builtin_amdgcn_s_waitcnt(0);
        unsigned nloc = b.st[0], nx = b.st[1];
        if (nloc == 0u) { xcd_barrier_complete(bar, b.x, nloc, nx); b.st[0] = nloc; b.st[1] = nx; }
        const unsigned old = xb_add(&bar[XB_XSUB(b.x)], 1u);
        const unsigned gen = old / nloc;
        if (old + 1u == (gen + 1u) * nloc) {
            __builtin_amdgcn_fence(__ATOMIC_RELEASE, "agent");
            asm volatile("s_waitcnt vmcnt(0)" ::: "memory");
            const unsigned og = xb_add(&bar[XB_TOP], 1u);
            const unsigned tg = og / nx;
            if (og + 1u == (tg + 1u) * nx) xb_add(&bar[XB_TOPGEN], 1u);
            else XB_SPIN(xb_ld(&bar[XB_TOPGEN]) == tg, bar);
            __builtin_amdgcn_fence(__ATOMIC_ACQUIRE, "agent");
            xb_add(&bar[XB_XGEN(b.x)], 1u);
            asm volatile("s_waitcnt vmcnt(0)" ::: "memory");
        } else {
            XB_SPIN(xb_ld(&bar[XB_XGEN(b.x)]) == gen, bar);
            __builtin_amdgcn_fence(__ATOMIC_ACQUIRE, "agent");
            asm volatile("s_waitcnt vmcnt(0)" ::: "memory");
        }
    }
    __syncthreads();
}
namespace pg8 {
#define PG8_LAS __attribute__((address_space(3)))
typedef unsigned short bf16_t;
typedef short bf16x8 __attribute__((ext_vector_type(8)));
typedef float f32x4 __attribute__((ext_vector_type(4)));
typedef unsigned u32x4 __attribute__((ext_vector_type(4)));
constexpr int BM = 256, BK = 64, HALF = 128, HTB = HALF * BK * 2  , STAGE_BYTES = 8 * HTB, NXCD = 8, WGM = 8;

__host__ __device__ __forceinline__ int lds_byte(int r, int c) { const int st = (r >> 4) * 2 + (c >> 5), rr = r & 15, cc = c & 31, ob = rr * 64 + cc * 2; return st * 1024 + (ob ^ (((ob >> 9) & 1) << 5)); }
__host__ __device__ __forceinline__ void stage_rc(int b, int& R, int& C) { const int st = b / 1024, sb = b % 1024, swz = sb ^ (((sb >> 9) & 1) << 5); R = (st >> 1) * 16 + swz / 64; C = (st & 1) * 32 + (swz % 64) / 2; }
__host__ __device__ __forceinline__ int perm32(int rho) { const int n = rho >> 4, i = rho & 15; return 8 * (i >> 2) + 4 * n + (i & 3); }

struct Unit { int pm, pn; };
struct Gemm { const bf16_t* A; const bf16_t* Bt; int M, N, K; };

struct StaticOrder {
    int nM, nN, nwg, G, c;
    __host__ __device__ void init(int M, int N, int G_, int c_) { nM = M / BM; nN = N / BM; nwg = nM * nN; G = G_; c = c_; }
    __host__ __device__ bool next(int i, Unit& u) const {
        const long L = (long)i * G + c; if (L >= nwg) return false;
        int wgid = (int)L; { const int q = nwg / NXCD, r = nwg % NXCD, xcd = wgid % NXCD, off = wgid / NXCD; wgid = (xcd < r ? xcd * (q + 1) : r * (q + 1) + (xcd - r) * q) + off; }
        const int nig = WGM * nN, gid = wgid / nig, fm = gid * WGM, gsz = (nM - fm) < WGM ? (nM - fm) : WGM;
        u.pm = fm + ((wgid % nig) % gsz); u.pn = (wgid % nig) / gsz; return true;
    }
    __device__ __forceinline__ void a_ready(const Unit&) const {}
    __device__ __forceinline__ void done(const Unit&) const {}
};
__device__ __forceinline__ unsigned cvt_pk_bf16(float lo, float hi) { unsigned r; asm volatile("v_cvt_pk_bf16_f32 %0, %1, %2" : "=v"(r) : "v"(lo), "v"(hi)); return r; }
template <class Epi, class Sched, bool STAMP = false>
__device__ __forceinline__ void gemm_phase(PG8_LAS unsigned char* lds, const Gemm g, const Sched& S, const Epi& E, unsigned long long* stamps) {
    int tid_l = threadIdx.x; asm volatile("" : "+v"(tid_l));
    const int tid = tid_l, wid = __builtin_amdgcn_readfirstlane(tid >> 6), lane = tid & 63, wr = wid >> 2, wc = wid & 3, fr = lane & 15, fq = lane >> 4;
    const int K = g.K, nt = K / BK;
    int ts_lo = 0, ts_hi = 0, nts = 0; const unsigned long long rt_entry = STAMP ? (unsigned long long)wall_clock64() : 0ull;
#define PG8_STAMP() do { if (STAMP && wid == 0 && nts < 64) { const unsigned long long _c = (unsigned long long)clock64(); \
        ts_lo = (lane == nts) ? (int)(unsigned)_c : ts_lo; ts_hi = (lane == nts) ? (int)(unsigned)(_c >> 32) : ts_hi; ++nts; } } while (0)
    PG8_STAMP();
    unsigned voffA[2], voffB[2];
#pragma unroll
    for (int i = 0; i < 2; ++i) { int R, C; stage_rc(tid * 16 + i * 8192, R, C); const int Rb = Epi::PERM ? ((R & ~31) + perm32(R & 31)) : R;
        voffA[i] = (unsigned)(R * K + C) * 2u; voffB[i] = (unsigned)(Rb * K + C) * 2u; }
    const size_t kstep = (size_t)(BK * 2);
    const size_t hstep = (size_t)HALF * K * 2;
    const size_t tstep = 2 * hstep;
    const unsigned ldsw = (unsigned)wid * 1024u;
    const int aoff = lds_byte(wr * 64 + fr, fq * 8), boff = lds_byte(wc * 32 + fr, fq * 8);
#define PG8_SA(b, h) (((b) * 2 + (h)) * HTB)
#define PG8_SB(b, h) ((4 + (b) * 2 + (h)) * HTB)
#define PG8_STAGE(bufoff, gbase, voff) do { _Pragma("unroll") for (int _i = 0; _i < 2; ++_i) \
        __builtin_amdgcn_global_load_lds((const unsigned*)((const char*)(gbase) + (voff)[_i]), (PG8_LAS unsigned*)(lds + (bufoff) + ldsw + _i * 8192), 16, 0, 0); } while (0)
#define PG8_LDA(dst, b, h) do { _Pragma("unroll") for (int m = 0; m < 4; ++m) _Pragma("unroll") for (int k = 0; k < 2; ++k) dst[m][k] = *(const PG8_LAS bf16x8*)(lds + PG8_SA(b, h) + aoff + m * 2048 + k * 1024); } while (0)
#define PG8_LDB(dst, b, h) do { _Pragma("unroll") for (int n = 0; n < 2; ++n) _Pragma("unroll") for (int k = 0; k < 2; ++k) dst[n][k] = *(const PG8_LAS bf16x8*)(lds + PG8_SB(b, h) + boff + n * 2048 + k * 1024); } while (0)
#define PG8_MMA(ai, bj, At, Bt) do { __builtin_amdgcn_s_setprio(1); _Pragma("unroll") for (int m = 0; m < 4; ++m) _Pragma("unroll") for (int n = 0; n < 2; ++n) _Pragma("unroll") for (int k = 0; k < 2; ++k) \
        acc[ai][bj][m][n] = __builtin_amdgcn_mfma_f32_16x16x32_bf16(Bt[n][k], At[m][k], acc[ai][bj][m][n], 0, 0, 0); __builtin_amdgcn_s_setprio(0); } while (0)
#define PG8_WAIT_V(n) asm volatile("s_waitcnt vmcnt(" #n ")" ::: "memory")
#define PG8_WAIT_L(n) asm volatile("s_waitcnt lgkmcnt(" #n ")" ::: "memory")
#define PG8_BAR __builtin_amdgcn_s_barrier()
#define PG8_SCHED __builtin_amdgcn_sched_barrier(0)
    Unit cur, nxt; int ui = 0;
    if (!S.next(0, cur)) return;
    f32x4 acc[2][2][4][2];
#pragma unroll
    for (int a = 0; a < 2; ++a)
#pragma unroll
        for (int b = 0; b < 2; ++b)
#pragma unroll
            for (int m = 0; m < 4; ++m)
#pragma unroll
                for (int n = 0; n < 2; ++n) acc[a][b][m][n] = (f32x4){0.f, 0.f, 0.f, 0.f};
    bf16x8 At[4][2], B0[2][2], B1[2][2];
    const char* cA = (const char*)g.A + (size_t)cur.pm * tstep; const char* cB = (const char*)g.Bt + (size_t)cur.pn * tstep;
    S.a_ready(cur);
    PG8_STAGE(PG8_SB(0, 0), cB, voffB); PG8_STAGE(PG8_SA(0, 0), cA, voffA); PG8_STAGE(PG8_SB(0, 1), cB + hstep, voffB); PG8_STAGE(PG8_SA(0, 1), cA + hstep, voffA);
    if (wr == 1) PG8_BAR;
    PG8_WAIT_V(4); PG8_BAR;
    PG8_STAGE(PG8_SB(1, 0), cB + kstep, voffB); PG8_STAGE(PG8_SA(1, 0), cA + kstep, voffA); PG8_STAGE(PG8_SB(1, 1), cB + hstep + kstep, voffB);
    PG8_WAIT_V(6); PG8_BAR;
    PG8_STAMP();
    for (;;) {
        const bool has_next = S.next(ui + 1, nxt);
        const char* nA = has_next ? (const char*)g.A + (size_t)nxt.pm * tstep : cA; const char* nB = has_next ? (const char*)g.Bt + (size_t)nxt.pn * tstep : cB;
        for (int t = 0; t < nt; t += 2) {
            const bool last = (t == nt - 2);
            const char* a1 = cA + (size_t)(t + 1) * kstep;
            const char* a2 = last ? nA : cA + (size_t)(t + 2) * kstep; const char* b2 = last ? nB : cB + (size_t)(t + 2) * kstep;
            const char* a3 = a2 + kstep; const char* b3 = b2 + kstep;
            if (last && has_next) S.a_ready(nxt);
            PG8_LDB(B0, 0, 0); PG8_SCHED; PG8_LDA(At, 0, 0); PG8_STAGE(PG8_SA(1, 1), a1 + hstep, voffA);
            PG8_WAIT_L(8); PG8_BAR; PG8_WAIT_L(0); PG8_MMA(0, 0, At, B0); PG8_BAR; PG8_SCHED;
            PG8_LDB(B1, 0, 1); PG8_STAGE(PG8_SB(0, 0), b2, voffB);
            PG8_BAR; PG8_WAIT_L(0); PG8_MMA(0, 1, At, B1); PG8_BAR;
            PG8_LDA(At, 0, 1); PG8_STAGE(PG8_SA(0, 0), a2, voffA);
            PG8_BAR; PG8_WAIT_L(0); PG8_MMA(1, 0, At, B0); PG8_BAR; PG8_SCHED;
            PG8_STAGE(PG8_SB(0, 1), b2 + hstep, voffB);
            PG8_WAIT_V(6); PG8_BAR; PG8_MMA(1, 1, At, B1); PG8_BAR;
            PG8_LDB(B0, 1, 0); PG8_SCHED; PG8_LDA(At, 1, 0); PG8_STAGE(PG8_SA(0, 1), a2 + hstep, voffA);
            PG8_WAIT_L(8); PG8_BAR; PG8_WAIT_L(0); PG8_MMA(0, 0, At, B0); PG8_BAR; PG8_SCHED;
            PG8_LDB(B1, 1, 1); PG8_STAGE(PG8_SB(1, 0), b3, voffB);
            PG8_BAR; PG8_WAIT_L(0); PG8_MMA(0, 1, At, B1); PG8_BAR;
            PG8_LDA(At, 1, 1); PG8_STAGE(PG8_SA(1, 0), a3, voffA);
            PG8_BAR; PG8_WAIT_L(0); PG8_MMA(1, 0, At, B0); PG8_BAR; PG8_SCHED;
            PG8_STAGE(PG8_SB(1, 1), b3 + hstep, voffB);
            PG8_WAIT_V(6); PG8_BAR; PG8_MMA(1, 1, At, B1); PG8_BAR;
        }
        PG8_STAMP();
        if constexpr (!Epi::AFTER_DRAIN) { E(acc, cur, wr, wc, fr, fq); S.done(cur); }
        PG8_STAMP();
        if (!has_next) break;
#pragma unroll
        for (int a = 0; a < 2; ++a)
#pragma unroll
            for (int b = 0; b < 2; ++b)
#pragma unroll
                for (int m = 0; m < 4; ++m)
#pragma unroll
                    for (int n = 0; n < 2; ++n) acc[a][b][m][n] = (f32x4){0.f, 0.f, 0.f, 0.f};
        cur = nxt; cA = nA; cB = nB; ++ui;
    }
    PG8_WAIT_V(0);
    if (wr == 0) PG8_BAR;
    PG8_BAR;
    if constexpr (Epi::AFTER_DRAIN) { E.fused(acc, cur, wr, wc, fr, fq, lds, wid, lane); S.done(cur); }
    PG8_STAMP();
    if (STAMP && wid == 0) { stamps[lane] = lane < nts ? (((unsigned long long)(unsigned)ts_hi << 32) | (unsigned)ts_lo) : 0ull;
        if (lane == 62) stamps[62] = rt_entry; if (lane == 63) stamps[63] = (unsigned long long)wall_clock64(); }
#undef PG8_STAMP
#undef PG8_SA
#undef PG8_SB
#undef PG8_STAGE
#undef PG8_LDA
#undef PG8_LDB
#undef PG8_MMA
#undef PG8_WAIT_V
#undef PG8_WAIT_L
#undef PG8_BAR
#undef PG8_SCHED
}
}
using pg8::bf16_t; using pg8::bf16x8; using pg8::f32x4; using pg8::Unit;
#define LAS __attribute__((address_space(3)))

constexpr int D = 1024, NB = 4, SEQ = 8192, MLAT = NB * SEQ, CTXL = 256, MCTX = NB * CTXL, MALL = MLAT + MCTX;
constexpr int FF = 2816, NT = 512;
constexpr int LDS_BYTES = 147456;

constexpr size_t al256(size_t x) { return (x + 255) & ~(size_t)255; }
constexpr size_t SZ_WGU = (size_t)5632 * 1024 * 2, SZ_WDN = (size_t)1024 * 2816 * 2;
constexpr size_t WS_WGU = 0;
constexpr size_t WS_WDN = WS_WGU + 4 * SZ_WGU;
constexpr size_t WS_WRW = WS_WDN + 4 * SZ_WDN;
constexpr size_t WS_WG2 = WS_WRW + (size_t)3584 * 2048 * 2;
constexpr size_t WS_WO = WS_WG2 + (size_t)1024 * 256 * 2;
constexpr size_t WS_W2T = WS_WO + (size_t)1024 * 1024 * 2;
constexpr size_t WS_A2T = WS_W2T + (size_t)2 * 1024 * 64 * 2;
constexpr size_t WS_WIN = WS_A2T + (size_t)2 * 1024 * 64 * 2;
constexpr size_t WS_WOUT = WS_WIN + (size_t)3072 * 1024 * 2;
constexpr size_t WS_MOD = WS_WOUT + (size_t)1024 * 1024 * 2;
constexpr size_t WS_HID2 = WS_MOD + al256((size_t)2 * 5 * 9216 * 4);
constexpr size_t WS_W3T = WS_HID2 + (size_t)8192 * 256 * 2;
constexpr size_t WS_XC = WS_W3T + (size_t)2048 * 256 * 2;
constexpr size_t WS_BSUM = WS_XC + (size_t)1024 * 1024 * 4;
constexpr size_t WS_R1 = WS_BSUM + (size_t)2 * 32768 * 16 * 4;
constexpr size_t SZ_R1 = (size_t)MALL * 2048 * 2;
constexpr size_t WS_R2 = WS_R1 + SZ_R1;
constexpr size_t SZ_R2 = (size_t)MALL * 1024 * 2 * 3;
constexpr size_t WS_R3 = WS_R2 + SZ_R2;
constexpr size_t SZ_R3 = (size_t)MALL * 512 * 2;
constexpr size_t WS_BAR = WS_R3 + SZ_R3;
constexpr size_t WS_END = WS_BAR + (size_t)XCD_BAR_WORDS * 4;

struct Params { const float* in[38]; float* out; unsigned char* ws; };
enum { I_X = 0, I_C, I_CTX, I_CCTX, I_MODW, I_MODB, I_NORMG, I_WGU, I_WDN, I_MIX, I_WRKV, I_WO, I_W0, I_W1, I_W2, I_A0, I_A1, I_A2, I_G1, I_G2,
       I_KK, I_KA, I_RK, I_LNG, I_LNB, I_HWIN, I_HCW, I_HCB, I_FW1, I_FB1, I_FFREQ, I_FW2, I_FB2, I_FW3, I_DELTAS, I_HBIAS, I_HWOUT, I_FINALG };

__device__ __forceinline__ int ltid() { int t = threadIdx.x; asm volatile("" : "+v"(t)); return t; }
__device__ __forceinline__ float bf2f(unsigned short b) { return __uint_as_float(((unsigned)b) << 16); }
__device__ __forceinline__ float bflo(unsigned u) { return __uint_as_float(u << 16); }
__device__ __forceinline__ float bfhi(unsigned u) { return __uint_as_float(u & 0xffff0000u); }
typedef __bf16 bf2_t __attribute__((ext_vector_type(2)));
typedef float f2_t __attribute__((ext_vector_type(2)));
__device__ __forceinline__ unsigned pk2(float lo, float hi) { const f2_t f = {lo, hi}; const bf2_t b = __builtin_convertvector(f, bf2_t); return __builtin_bit_cast(unsigned, b); }
__device__ __forceinline__ float frcp(float x) { return __builtin_amdgcn_rcpf(x); }
__device__ __forceinline__ float sigm(float x) { return frcp(1.f + __expf(-x)); }
__device__ __forceinline__ float wave_sum(float v) {
#pragma unroll
    for (int o = 32; o >= 1; o >>= 1) v += __shfl_xor(v, o, 64);
    return v;
}

__device__ __forceinline__ void grid_barrier(unsigned* ctr, unsigned& epoch) {
    asm volatile("s_waitcnt vmcnt(0) lgkmcnt(0)" ::: "memory");
    __syncthreads();
    epoch += 1u;
    if (threadIdx.x == 0) {
        __builtin_amdgcn_fence(__ATOMIC_RELEASE, "agent");
        asm volatile("s_waitcnt vmcnt(0)" ::: "memory");
        __hip_atomic_fetch_add(ctr, 1u, __ATOMIC_RELAXED, __HIP_MEMORY_SCOPE_AGENT);
        const unsigned target = epoch * gridDim.x;
        while (__hip_atomic_load(ctr, __ATOMIC_RELAXED, __HIP_MEMORY_SCOPE_AGENT) < target) __builtin_amdgcn_s_sleep(1);
    }
    __syncthreads();
    __builtin_amdgcn_fence(__ATOMIC_ACQUIRE, "agent");
    asm volatile("s_waitcnt vmcnt(0)" ::: "memory");
}

template <class F> __device__ void transpose_cvt(const F f, bf16_t* dst, int N, int K, float* tile) {
    const int tid = ltid(), ntn = N >> 6, ntk = K >> 6;
    for (int t = blockIdx.x; t < ntn * ntk; t += gridDim.x) {
        const int tn = t % ntn, tk = t / ntn, n0 = tn * 64, k0 = tk * 64;
#pragma unroll
        for (int i = 0; i < 8; ++i) { const int r = (tid >> 6) + 8 * i, c = tid & 63; tile[r * 65 + c] = f(n0 + c, k0 + r); }
        __syncthreads();
#pragma unroll
        for (int i = 0; i < 4; ++i) { const int idx = tid + 512 * i, nn = idx >> 5, kp = idx & 31;
            *(unsigned*)(dst + (size_t)(n0 + nn) * K + k0 + 2 * kp) = pk2(tile[(2 * kp) * 65 + nn], tile[(2 * kp + 1) * 65 + nn]); }
        __syncthreads();
    }
}
struct FGu { const float* w; __device__ float operator()(int n, int k) const { const int pn = n >> 8, r = n & 255; const int col = (r < 128) ? (pn * 128 + r) : (FF + pn * 128 + (r - 128)); return w[(size_t)k * 5632 + col]; } };
struct FPlain { const float* w; int ld; __device__ float operator()(int n, int k) const { return w[(size_t)k * ld + n]; } };
struct FRw { const float *rkv, *w1, *a1, *g1, *mix;
    __device__ float operator()(int n, int k) const {
        const int kk = k & 1023; float v; int mi;
        if (n < 3072) { const int j = n >> 10; v = rkv[((size_t)j * 1024 + kk) * 1024 + (n & 1023)]; mi = (j == 0) ? 0 : (j == 1 ? 2 : 3); }
        else if (n < 3200) { const int q = n - 3072; v = w1[((size_t)(q >> 6) * 1024 + kk) * 64 + (q & 63)]; mi = 1; }
        else if (n < 3328) { const int q = n - 3200; v = a1[((size_t)(q >> 6) * 1024 + kk) * 64 + (q & 63)]; mi = 4; }
        else if (n < 3488) { const int q = n - 3328; v = g1[(size_t)kk * 160 + q]; mi = 5; }
        else return 0.f;
        if (k >= 1024) v *= mix[mi * 1024 + kk];
        return v; } };
struct FG2 { const float* g2; __device__ float operator()(int n, int k) const { return k < 160 ? g2[(size_t)k * 1024 + n] : 0.f; } };
struct FLora2 { const float* w2; __device__ float operator()(int n, int k) const { const int dir = n >> 10; return w2[((size_t)dir * 64 + k) * 1024 + (n & 1023)]; } };

__device__ void mod_phase(const Params& p, float* mod, float* ldsf) {
    const int tid = ltid(), lane = tid & 63, wave = tid >> 6;
    float* sc = ldsf; float* red = ldsf + 5 * 1024;
    for (int i = tid; i < 5 * 1024; i += NT) { const int m = i >> 10, k = i & 1023; const float v = m < 4 ? p.in[I_C][m * 1024 + k] : p.in[I_CCTX][k]; sc[i] = v * sigm(v); }
    __syncthreads();
    const int kq = lane >> 4, cq = lane & 15;
    for (int cb = blockIdx.x; cb < 288; cb += gridDim.x) {
        const int layer = cb / 144, col0 = (cb % 144) * 64;
        const float* W = p.in[I_MODW] + (size_t)layer * 1024 * 9216;
        float acc[5][4];
#pragma unroll
        for (int m = 0; m < 5; ++m)
#pragma unroll
            for (int e = 0; e < 4; ++e) acc[m][e] = 0.f;
#pragma unroll 8
        for (int i = 0; i < 32; ++i) { const int k = wave * 128 + 4 * i + kq; const float4 w = *(const float4*)(W + (size_t)k * 9216 + col0 + 4 * cq);
#pragma unroll
            for (int m = 0; m < 5; ++m) { const float s = sc[m * 1024 + k]; acc[m][0] += s * w.x; acc[m][1] += s * w.y; acc[m][2] += s * w.z; acc[m][3] += s * w.w; } }
#pragma unroll
        for (int m = 0; m < 5; ++m)
#pragma unroll
            for (int e = 0; e < 4; ++e) { float a = acc[m][e]; a += __shfl_xor(a, 16, 64); a += __shfl_xor(a, 32, 64); if (kq == 0) red[(wave * 5 + m) * 64 + 4 * cq + e] = a; }
        __syncthreads();
        if (tid < 320) { const int m = tid >> 6, cc = tid & 63; float s = 0.f;
#pragma unroll
            for (int w = 0; w < 8; ++w) s += red[(w * 5 + m) * 64 + cc];
            mod[((size_t)layer * 5 + m) * 9216 + col0 + cc] = s + p.in[I_MODB][layer * 9216 + col0 + cc]; }
        __syncthreads();
    }
}

__device__ void hid_phase(const Params& p, bf16_t* hid2b, float* ldsf) {
    const int tid = ltid(), rr = tid >> 6, j = tid & 63;
    float* zs = ldsf; float* h1 = ldsf + 8 * 36;
    const float *w1 = p.in[I_FW1], *b1 = p.in[I_FB1], *fq = p.in[I_FFREQ], *w2 = p.in[I_FW2], *b2 = p.in[I_FB2];
    for (int it = blockIdx.x; it < 1024; it += gridDim.x) {
        const int l = it * 8 + rr;
        if (j < 33) { float z;
            if (j == 0) z = (float)l / 8191.f;
            else { const int bi = (j - 1) & 15; const float band = 1e-4f + (float)bi * ((15.f - 1e-4f) / 15.f); const float ang = (7.66990393942820614859e-4f * (float)l) * band; z = (j <= 16) ? cosf(ang) : -sinf(ang); }
            zs[rr * 36 + j] = z; }
        __syncthreads();
        float a = b1[j];
        for (int i = 0; i < 33; ++i) a += zs[rr * 36 + i] * w1[i * 64 + j];
        h1[rr * 64 + j] = sinf(fq[j] * a);
        __syncthreads();
        float a2 = b2[j];
        for (int i = 0; i < 64; ++i) a2 += h1[rr * 64 + i] * w2[i * 64 + j];
        bf16_t* o = hid2b + (size_t)l * 256 + j;
        o[0] = (bf16_t)(pk2(sinf(fq[64 + j] * a2), 0.f) & 0xffffu); o[64] = 0; o[128] = 0; o[192] = 0;
        __syncthreads();
    }
}
struct FW3 { const float* w3; __device__ float operator()(int n, int k) const { return k < 64 ? w3[(size_t)k * 2048 + n] : 0.f; } };

__device__ void prenorm_phase(const float* xl, const float* xc, const float* g, const float* mod, int ish, int isc, bf16_t* out, int out_ld, int nrows) {
    const int lane = ltid() & 63, gw = blockIdx.x * 8 + (ltid() >> 6), nw = gridDim.x * 8;
    for (int r = gw; r < nrows; r += nw) {
        const float* src = r < MLAT ? xl + (size_t)r * 1024 : xc + (size_t)(r - MLAT) * 1024;
        const int m = r < MLAT ? (r >> 13) : 4;
        const float* sh = mod + (size_t)m * 9216 + ish * 1024; const float* sc = mod + (size_t)m * 9216 + isc * 1024;
        float4 v[4]; float ss = 0.f;
#pragma unroll
        for (int i = 0; i < 4; ++i) { v[i] = *(const float4*)(src + 4 * (lane + 64 * i)); ss += v[i].x * v[i].x + v[i].y * v[i].y + v[i].z * v[i].z + v[i].w * v[i].w; }
        ss = wave_sum(ss);
        const float rstd = rsqrtf(ss * (1.f / 1024.f) + 1e-6f);
#pragma unroll
        for (int i = 0; i < 4; ++i) { const int c = 4 * (lane + 64 * i);
            const float4 g4 = *(const float4*)(g + c), s4 = *(const float4*)(sh + c), c4 = *(const float4*)(sc + c);
            const float o0 = v[i].x * rstd * g4.x * (1.f + c4.x) + s4.x, o1 = v[i].y * rstd * g4.y * (1.f + c4.y) + s4.y;
            const float o2 = v[i].z * rstd * g4.z * (1.f + c4.z) + s4.z, o3 = v[i].w * rstd * g4.w * (1.f + c4.w) + s4.w;
            uint2 o; o.x = pk2(o0, o1); o.y = pk2(o2, o3);
            *(uint2*)(out + (size_t)r * out_ld + c) = o; }
    }
}
__device__ void final_norm_phase(float* x, const float* g) {
    const int lane = ltid() & 63, gw = blockIdx.x * 8 + (ltid() >> 6), nw = gridDim.x * 8;
    for (int r = gw; r < MLAT; r += nw) {
        float* src = x + (size_t)r * 1024; float4 v[4]; float ss = 0.f;
#pragma unroll
        for (int i = 0; i < 4; ++i) { v[i] = *(const float4*)(src + 4 * (lane + 64 * i)); ss += v[i].x * v[i].x + v[i].y * v[i].y + v[i].z * v[i].z + v[i].w * v[i].w; }
        ss = wave_sum(ss);
        const float rstd = rsqrtf(ss * (1.f / 1024.f) + 1e-6f);
#pragma unroll
        for (int i = 0; i < 4; ++i) { const int c = 4 * (lane + 64 * i); const float4 g4 = *(const float4*)(g + c);
            float4 o; o.x = v[i].x * rstd * g4.x; o.y = v[i].y * rstd * g4.y; o.z = v[i].z * rstd * g4.z; o.w = v[i].w * rstd * g4.w;
            *(float4*)(src + c) = o; }
    }
}

struct EpiSwiglu {
    static constexpr bool PERM = true, AFTER_DRAIN = false;
    bf16_t* H;
    __device__ __forceinline__ void operator()(const f32x4 (&acc)[2][2][4][2], const Unit& u, int wr, int wc, int fr, int fq) const {
        const int row0 = u.pm * 256 + wr * 64 + fr, col0 = u.pn * 128 + wc * 32 + 8 * fq;
#pragma unroll
        for (int ai = 0; ai < 2; ++ai)
#pragma unroll
            for (int m = 0; m < 4; ++m) { const f32x4 g0 = acc[ai][0][m][0], g1 = acc[ai][0][m][1], u0 = acc[ai][1][m][0], u1 = acc[ai][1][m][1];
                float h[8];
#pragma unroll
                for (int e = 0; e < 4; ++e) { h[e] = g0[e] * sigm(g0[e]) * u0[e]; h[4 + e] = g1[e] * sigm(g1[e]) * u1[e]; }
                uint4 o; o.x = pk2(h[0], h[1]); o.y = pk2(h[2], h[3]); o.z = pk2(h[4], h[5]); o.w = pk2(h[6], h[7]);
                *(uint4*)(H + (size_t)(row0 + ai * 128 + m * 16) * FF + col0) = o; }
    }
};
struct EpiResid {
    static constexpr bool PERM = false, AFTER_DRAIN = false;
    const float* src_l; float* dst_l; const float* src_c; float* dst_c; const float* mod; int ig; float coef;
    __device__ __forceinline__ void operator()(const f32x4 (&acc)[2][2][4][2], const Unit& u, int wr, int wc, int fr, int fq) const {
        const bool lat = u.pm < 128; const float* src = lat ? src_l : src_c; float* dst = lat ? dst_l : dst_c;
        const int rbase = (lat ? u.pm : u.pm - 128) * 256 + wr * 64 + fr, mi = lat ? (u.pm >> 5) : 4, col0 = u.pn * 256 + wc * 32 + 4 * fq;
        const float* gp = mod + (size_t)mi * 9216 + ig * 1024 + col0;
        f32x4 gv[2][2];
#pragma unroll
        for (int bj = 0; bj < 2; ++bj)
#pragma unroll
            for (int n = 0; n < 2; ++n) gv[bj][n] = *(const f32x4*)(gp + bj * 128 + n * 16) * coef;
#pragma unroll
        for (int ai = 0; ai < 2; ++ai)
#pragma unroll
            for (int m = 0; m < 4; ++m) { const size_t ro = (size_t)(rbase + ai * 128 + m * 16) * 1024 + col0;
#pragma unroll
                for (int bj = 0; bj < 2; ++bj)
#pragma unroll
                    for (int n = 0; n < 2; ++n) { const size_t off = ro + bj * 128 + n * 16; const f32x4 s = *(const f32x4*)(src + off); *(f32x4*)(dst + off) = s + gv[bj][n] * acc[ai][bj][m][n]; } }
    }
};
template <class Epi> __device__ __forceinline__ void run_gemm(LAS unsigned char* lds, const bf16_t* A, const bf16_t* Bt, int M, int N, int K, const Epi& E) {
    asm volatile("" : "+s"(K));
    pg8::Gemm g{A, Bt, M, N, K}; pg8::StaticOrder S; S.init(M, N, (int)gridDim.x, (int)blockIdx.x);
    pg8::gemm_phase<Epi, pg8::StaticOrder, false>(lds, g, S, E, nullptr);
}
__device__ void dshift_phase(bf16_t* A2) {
    const int lane = ltid() & 63, gw = blockIdx.x * 8 + (ltid() >> 6), nw = gridDim.x * 8;
    for (int r0 = gw; r0 < MALL; r0 += 2 * nw) {
        uint4 hv[2][2], nv[2][2]; bool ok[2][2]; int rr[2];
#pragma unroll
        for (int k = 0; k < 2; ++k) { const int r = (r0 + k * nw < MALL) ? r0 + k * nw : r0; rr[k] = r;
#pragma unroll
            for (int i = 0; i < 2; ++i) { const int c = 8 * (lane + 64 * i), q = c >> 8; int nb = -1;
                if (r < MLAT) { const int t = r & 8191, gy = t >> 6, gx = t & 63;
                    if (q == 0) nb = gx > 0 ? r - 1 : -1; else if (q == 1) nb = gx < 63 ? r + 1 : -1; else if (q == 2) nb = gy > 0 ? r - 64 : -1; else nb = gy < 127 ? r + 64 : -1; }
                else { const int t = (r - MLAT) & 255; nb = ((q & 1) == 0) ? (t > 0 ? r - 1 : -1) : (t < 255 ? r + 1 : -1); }
                ok[k][i] = nb >= 0;
                hv[k][i] = *(const uint4*)(A2 + (size_t)r * 2048 + c);
                nv[k][i] = *(const uint4*)(A2 + (size_t)(nb >= 0 ? nb : r) * 2048 + c); } }
#pragma unroll
        for (int k = 0; k < 2; ++k) { if (k == 1 && r0 + nw >= MALL) break;
#pragma unroll
            for (int i = 0; i < 2; ++i) { const int c = 8 * (lane + 64 * i); const uint4 h = hv[k][i]; uint4 n = nv[k][i];
                if (!ok[k][i]) n = make_uint4(0u, 0u, 0u, 0u);
                uint4 o;
                o.x = pk2(bflo(n.x) - bflo(h.x), bfhi(n.x) - bfhi(h.x)); o.y = pk2(bflo(n.y) - bflo(h.y), bfhi(n.y) - bfhi(h.y));
                o.z = pk2(bflo(n.z) - bflo(h.z), bfhi(n.z) - bfhi(h.z)); o.w = pk2(bflo(n.w) - bflo(h.w), bfhi(n.w) - bfhi(h.w));
                *(uint4*)(A2 + (size_t)rr[k] * 2048 + 1024 + c) = o; } }
    }
}
__device__ __forceinline__ uint4 pack8(const f32x4 a, const f32x4 b) { uint4 o; o.x = pk2(a[0], a[1]); o.y = pk2(a[2], a[3]); o.z = pk2(b[0], b[1]); o.w = pk2(b[2], b[3]); return o; }
__device__ __forceinline__ float tanh_(float x) { return 1.f - 2.f * frcp(1.f + __expf(2.f * x)); }
struct EpiRwkv {
    static constexpr bool PERM = true, AFTER_DRAIN = false;
    bf16_t *rkv, *l1;
    __device__ __forceinline__ void operator()(const f32x4 (&acc)[2][2][4][2], const Unit& u, int wr, int wc, int fr, int fq) const {
        const int row0 = u.pm * 256 + wr * 64 + fr, cw = wc * 32 + 8 * fq;
        bf16_t* const l1w = l1; bf16_t* const l1a = l1 + (size_t)MALL * 128; bf16_t* const l1g = l1 + (size_t)MALL * 256;
        const int mode = u.pn < 12 ? 0 : (u.pn == 12 ? 1 : 2);
        bf16_t* base0; bf16_t* base1; int ld;
        if (mode == 0) { base0 = rkv + (size_t)(u.pn >> 2) * ((size_t)MALL * 1024) + (u.pn & 3) * 256 + cw; base1 = base0 + 128; ld = 1024; }
        else if (mode == 1) { base0 = l1w + cw; base1 = l1a + cw; ld = 128; }
        else { base0 = l1g + cw; base1 = l1g + 128 + cw; ld = 256; }
#pragma unroll
        for (int ai = 0; ai < 2; ++ai)
#pragma unroll
            for (int m = 0; m < 4; ++m) { const size_t ro = (size_t)(row0 + ai * 128 + m * 16) * ld;
#pragma unroll
                for (int bj = 0; bj < 2; ++bj) { f32x4 t0 = acc[ai][bj][m][0], t1 = acc[ai][bj][m][1];
                    if (mode == 1 && bj == 0) {
#pragma unroll
                        for (int e = 0; e < 4; ++e) { t0[e] = tanh_(t0[e]); t1[e] = tanh_(t1[e]); } }
                    if (mode == 2) { const bool live = (bj * 128 + cw) < 160;
#pragma unroll
                        for (int e = 0; e < 4; ++e) { t0[e] = live ? sigm(t0[e]) : 0.f; t1[e] = live ? sigm(t1[e]) : 0.f; } }
                    *(uint4*)((bj ? base1 : base0) + ro) = pack8(t0, t1); } }
    }
};
struct EpiG {
    static constexpr bool PERM = true, AFTER_DRAIN = false;
    const bf16_t* yn; bf16_t* ao;
    __device__ __forceinline__ void operator()(const f32x4 (&acc)[2][2][4][2], const Unit& u, int wr, int wc, int fr, int fq) const {
        const int row0 = u.pm * 256 + wr * 64 + fr, col0 = u.pn * 256 + wc * 32 + 8 * fq;
#pragma unroll
        for (int ai = 0; ai < 2; ++ai)
#pragma unroll
            for (int m = 0; m < 4; ++m)
#pragma unroll
                for (int bj = 0; bj < 2; ++bj) { const size_t off = (size_t)(row0 + ai * 128 + m * 16) * 1024 + col0 + bj * 128;
                    const uint4 y = *(const uint4*)(yn + off); const f32x4 a0 = acc[ai][bj][m][0], a1 = acc[ai][bj][m][1];
                    uint4 o; o.x = pk2(bflo(y.x) * a0[0], bfhi(y.x) * a0[1]); o.y = pk2(bflo(y.y) * a0[2], bfhi(y.y) * a0[3]);
                    o.z = pk2(bflo(y.z) * a1[0], bfhi(y.z) * a1[1]); o.w = pk2(bflo(y.w) * a1[2], bfhi(y.w) * a1[3]);
                    *(uint4*)(ao + off) = o; asm volatile("" ::: "memory"); }
    }
};
struct EpiBf16Plain {
    static constexpr bool PERM = true, AFTER_DRAIN = false;
    bf16_t* O; int ld;
    __device__ __forceinline__ void operator()(const f32x4 (&acc)[2][2][4][2], const Unit& u, int wr, int wc, int fr, int fq) const {
        const int row0 = u.pm * 256 + wr * 64 + fr, col0 = u.pn * 256 + wc * 32 + 8 * fq;
#pragma unroll
        for (int ai = 0; ai < 2; ++ai)
#pragma unroll
            for (int m = 0; m < 4; ++m)
#pragma unroll
                for (int bj = 0; bj < 2; ++bj) *(uint4*)(O + (size_t)(row0 + ai * 128 + m * 16) * ld + col0 + bj * 128) = pack8(acc[ai][bj][m][0], acc[ai][bj][m][1]);
    }
};

#ifndef SCAN_DUP_LOADER
#define SCAN_DUP_LOADER 0
#endif
typedef float f2v __attribute__((ext_vector_type(2)));
template <int N> __device__ __forceinline__ float dpp_ror(float x) { return __int_as_float(__builtin_amdgcn_update_dpp(__float_as_int(x), __float_as_int(x), 0x120 + N, 0xf, 0xf, true)); }
__device__ __forceinline__ float row_allsum16(float x) { x += dpp_ror<8>(x); x += dpp_ror<4>(x); x += dpp_ror<2>(x); x += dpp_ror<1>(x); return x; }
__device__ __forceinline__ int scan_tokrow(int ci, int slot, int dir, int b) {
    if (ci < 4) { const int s = ci * 64 + slot; return MLAT + b * 256 + (dir ? 255 - s : s); }
    const int s = (ci - 4) * 64 + slot; return b * 8192 + (dir ? 8191 - s : s);
}
__device__ void scan_phase(const Params& p, unsigned char* ws, float* ldsf) {
    const int tid = ltid(), lane = tid & 63, wave = tid >> 6;
    const bf16_t* Rb = (const bf16_t*)(ws + WS_R2); const bf16_t* Kb = Rb + (size_t)MALL * 1024; const bf16_t* Vb = Kb + (size_t)MALL * 1024;
    const bf16_t* L1w = (const bf16_t*)(ws + WS_R3); const bf16_t* L1a = L1w + (size_t)MALL * 128;
    bf16_t* Yd = (bf16_t*)(ws + WS_R1);
    float* bsum = (float*)(ws + WS_BSUM);
    const bf16_t* w2t = (const bf16_t*)(ws + WS_W2T); const bf16_t* a2t = (const bf16_t*)(ws + WS_A2T);
    float* Wl = ldsf; float* KDl = ldsf + 4096; float* KKl = ldsf + 8192; float* KAl = ldsf + 12288; float* Rl = ldsf + 16384; float* Vl = ldsf + 20480; float* Yl = ldsf + 24576;
    for (int wi = blockIdx.x; wi < 256; wi += gridDim.x) {
        const int chain = wi >> 1, half = wi & 1, dir = chain >> 6, b = (chain >> 4) & 3, h = chain & 15;
        const int rr = tid >> 4, ks = tid & 15, slot2 = tid >> 3, cg8 = tid & 7, ch0 = h * 64 + 8 * cg8;
        const int mt = wave & 3, nh = wave >> 2, l15 = lane & 15, lq = lane >> 4;
        f2v S0 = {0.f, 0.f}, S1 = {0.f, 0.f}, S2 = {0.f, 0.f}, S3 = {0.f, 0.f};
        const int rp = (tid >> 4) & 15;
        float kkc[8], kac[8], rkc[8];
#pragma unroll
        for (int e = 0; e < 8; ++e) { kkc[e] = p.in[I_KK][ch0 + e]; kac[e] = p.in[I_KA][ch0 + e]; rkc[e] = p.in[I_RK][ch0 + e]; }
        bf16x8 bw[2][2], ba[2][2]; float w0v[2], a0v[2];
#pragma unroll
        for (int nt = 0; nt < 2; ++nt) { const int n = h * 64 + 32 * nh + 16 * nt + l15;
            w0v[nt] = p.in[I_W0][dir * 1024 + n]; a0v[nt] = p.in[I_A0][dir * 1024 + n];
#pragma unroll
            for (int k2 = 0; k2 < 2; ++k2) { bw[nt][k2] = *(const bf16x8*)(w2t + (size_t)(dir * 1024 + n) * 64 + k2 * 32 + lq * 8); ba[nt][k2] = *(const bf16x8*)(a2t + (size_t)(dir * 1024 + n) * 64 + k2 * 32 + lq * 8); } }
        bf16x8 paw[2], paa[2]; uint4 pk_, pv_, pr_;
#define SCAN_LOAD(ci) do { const int _ra = scan_tokrow((ci), 16 * mt + l15, dir, b); \
            paw[0] = *(const bf16x8*)(L1w + (size_t)_ra * 128 + dir * 64 + lq * 8); paw[1] = *(const bf16x8*)(L1w + (size_t)_ra * 128 + dir * 64 + 32 + lq * 8); \
            paa[0] = *(const bf16x8*)(L1a + (size_t)_ra * 128 + dir * 64 + lq * 8); paa[1] = *(const bf16x8*)(L1a + (size_t)_ra * 128 + dir * 64 + 32 + lq * 8); \
            const int _rb = scan_tokrow((ci), slot2, dir, b); \
            pk_ = *(const uint4*)(Kb + (size_t)_rb * 1024 + ch0); pv_ = *(const uint4*)(Vb + (size_t)_rb * 1024 + ch0); pr_ = *(const uint4*)(Rb + (size_t)_rb * 1024 + ch0); } while (0)
        SCAN_LOAD(0);
        for (int ci = 0; ci < 132; ++ci) {
            for (int lrep = 0; lrep < 1 + SCAN_DUP_LOADER; ++lrep) {
            {
                f32x4 cw[2], ca[2];
#pragma unroll
                for (int nt = 0; nt < 2; ++nt) { const f32x4 z = {0.f, 0.f, 0.f, 0.f};
                    cw[nt] = __builtin_amdgcn_mfma_f32_16x16x32_bf16(paw[0], bw[nt][0], z, 0, 0, 0); cw[nt] = __builtin_amdgcn_mfma_f32_16x16x32_bf16(paw[1], bw[nt][1], cw[nt], 0, 0, 0);
                    ca[nt] = __builtin_amdgcn_mfma_f32_16x16x32_bf16(paa[0], ba[nt][0], z, 0, 0, 0); ca[nt] = __builtin_amdgcn_mfma_f32_16x16x32_bf16(paa[1], ba[nt][1], ca[nt], 0, 0, 0); }
#pragma unroll
                for (int nt = 0; nt < 2; ++nt)
#pragma unroll
                    for (int j = 0; j < 4; ++j) { const int slot = 16 * mt + 4 * lq + j, chl = 32 * nh + 16 * nt + l15;
                        Wl[slot * 64 + chl] = __expf(-0.60653065971263342f * sigm(w0v[nt] + cw[nt][j]));
                        KAl[slot * 64 + chl] = sigm(a0v[nt] + ca[nt][j]); }
            }
            __syncthreads();
            {
                float k8[8], v8[8], r8[8];
                k8[0] = bflo(pk_.x); k8[1] = bfhi(pk_.x); k8[2] = bflo(pk_.y); k8[3] = bfhi(pk_.y); k8[4] = bflo(pk_.z); k8[5] = bfhi(pk_.z); k8[6] = bflo(pk_.w); k8[7] = bfhi(pk_.w);
                v8[0] = bflo(pv_.x); v8[1] = bfhi(pv_.x); v8[2] = bflo(pv_.y); v8[3] = bfhi(pv_.y); v8[4] = bflo(pv_.z); v8[5] = bfhi(pv_.z); v8[6] = bflo(pv_.w); v8[7] = bfhi(pv_.w);
                r8[0] = bflo(pr_.x); r8[1] = bfhi(pr_.x); r8[2] = bflo(pr_.y); r8[3] = bfhi(pr_.y); r8[4] = bflo(pr_.z); r8[5] = bfhi(pr_.z); r8[6] = bflo(pr_.w); r8[7] = bfhi(pr_.w);
                float kkr[8], ss = 0.f;
#pragma unroll
                for (int e = 0; e < 8; ++e) { kkr[e] = k8[e] * kkc[e]; ss += kkr[e] * kkr[e]; }
                ss += __shfl_xor(ss, 1, 64); ss += __shfl_xor(ss, 2, 64); ss += __shfl_xor(ss, 4, 64);
                const float rn = 1.f / fmaxf(sqrtf(ss), 1e-12f);
                const float4 a_lo = *(const float4*)(KAl + slot2 * 64 + 8 * cg8), a_hi = *(const float4*)(KAl + slot2 * 64 + 8 * cg8 + 4);
                const float av[8] = {a_lo.x, a_lo.y, a_lo.z, a_lo.w, a_hi.x, a_hi.y, a_hi.z, a_hi.w};
                float kd[8], kk[8], ka[8], bp = 0.f;
#pragma unroll
                for (int e = 0; e < 8; ++e) { kd[e] = k8[e] * (1.f + (av[e] - 1.f) * kac[e]); kk[e] = kkr[e] * rn; ka[e] = kk[e] * av[e]; bp += r8[e] * kd[e] * rkc[e]; }
                bp += __shfl_xor(bp, 1, 64); bp += __shfl_xor(bp, 2, 64); bp += __shfl_xor(bp, 4, 64);
                const int o = slot2 * 64 + 8 * cg8;
                *(float4*)(KDl + o) = make_float4(kd[0], kd[1], kd[2], kd[3]); *(float4*)(KDl + o + 4) = make_float4(kd[4], kd[5], kd[6], kd[7]);
                *(float4*)(KKl + o) = make_float4(kk[0], kk[1], kk[2], kk[3]); *(float4*)(KKl + o + 4) = make_float4(kk[4], kk[5], kk[6], kk[7]);
                *(float4*)(KAl + o) = make_float4(ka[0], ka[1], ka[2], ka[3]); *(float4*)(KAl + o + 4) = make_float4(ka[4], ka[5], ka[6], ka[7]);
                *(float4*)(Rl + o) = make_float4(r8[0], r8[1], r8[2], r8[3]); *(float4*)(Rl + o + 4) = make_float4(r8[4], r8[5], r8[6], r8[7]);
                *(float4*)(Vl + o) = make_float4(v8[0], v8[1], v8[2], v8[3]); *(float4*)(Vl + o + 4) = make_float4(v8[4], v8[5], v8[6], v8[7]);
                if (ci >= 4 && half == 0 && cg8 == 0) bsum[((size_t)dir * MLAT + scan_tokrow(ci, slot2, dir, b)) * 16 + h] = bp;
            }
            __syncthreads();
            }
            if (ci + 1 < 132) SCAN_LOAD(ci + 1);
            if (wave < 4) {
                float4 kkn = *(const float4*)(KKl + 4 * ks);
                f2v sa2 = S0 * kkn.x + S1 * kkn.y + S2 * kkn.z + S3 * kkn.w;
                sa2.x = row_allsum16(sa2.x); sa2.y = row_allsum16(sa2.y);
                f2v yk = {0.f, 0.f};
                float4 w4 = *(const float4*)(Wl + 4 * ks), ka4 = *(const float4*)(KAl + 4 * ks), kd4 = *(const float4*)(KDl + 4 * ks), r4 = *(const float4*)(Rl + 4 * ks);
                f2v v2 = {Vl[half * 32 + rp], Vl[half * 32 + rp + 16]};
                kkn = *(const float4*)(KKl + 64 + 4 * ks);
#pragma unroll 16
                for (int s = 0; s < 64; ++s) {
                    const int sn = (s + 1) & 63, sn2 = (s + 2) & 63;
                    const float4 w4n = *(const float4*)(Wl + sn * 64 + 4 * ks), ka4n = *(const float4*)(KAl + sn * 64 + 4 * ks);
                    const float4 kd4n = *(const float4*)(KDl + sn * 64 + 4 * ks), r4n = *(const float4*)(Rl + sn * 64 + 4 * ks);
                    const f2v v2n = {Vl[sn * 64 + half * 32 + rp], Vl[sn * 64 + half * 32 + rp + 16]};
                    const float4 kknn = *(const float4*)(KKl + sn2 * 64 + 4 * ks);
                    S0 = S0 * w4.x + (v2 * kd4.x - sa2 * ka4.x); S1 = S1 * w4.y + (v2 * kd4.y - sa2 * ka4.y);
                    S2 = S2 * w4.z + (v2 * kd4.z - sa2 * ka4.z); S3 = S3 * w4.w + (v2 * kd4.w - sa2 * ka4.w);
                    f2v y2 = S0 * r4.x + S1 * r4.y + S2 * r4.z + S3 * r4.w;
                    f2v n2 = S0 * kkn.x + S1 * kkn.y + S2 * kkn.z + S3 * kkn.w;
                    { f2v t; t.x = dpp_ror<8>(n2.x); t.y = dpp_ror<8>(n2.y); n2 += t; t.x = dpp_ror<8>(y2.x); t.y = dpp_ror<8>(y2.y); y2 += t; }
                    { f2v t; t.x = dpp_ror<4>(n2.x); t.y = dpp_ror<4>(n2.y); n2 += t; t.x = dpp_ror<4>(y2.x); t.y = dpp_ror<4>(y2.y); y2 += t; }
                    { f2v t; t.x = dpp_ror<2>(n2.x); t.y = dpp_ror<2>(n2.y); n2 += t; t.x = dpp_ror<2>(y2.x); t.y = dpp_ror<2>(y2.y); y2 += t; }
                    { f2v t; t.x = dpp_ror<1>(n2.x); t.y = dpp_ror<1>(n2.y); n2 += t; t.x = dpp_ror<1>(y2.x); t.y = dpp_ror<1>(y2.y); y2 += t; }
                    sa2 = n2;
                    if ((s & 15) == ks) yk = y2;
                    if ((s & 15) == 15) { Yl[((s & 48) + ks) * 32 + rp] = yk.x; Yl[((s & 48) + ks) * 32 + rp + 16] = yk.y; }
                    w4 = w4n; ka4 = ka4n; kd4 = kd4n; r4 = r4n; v2 = v2n; kkn = kknn;
                }
            }
            __syncthreads();
            if (ci >= 4) { const float4 y4 = *(const float4*)(Yl + slot2 * 32 + 4 * cg8); const int row = scan_tokrow(ci, slot2, dir, b);
                uint2 o; o.x = pk2(y4.x, y4.y); o.y = pk2(y4.z, y4.w);
                *(uint2*)(Yd + ((size_t)dir * MLAT + row) * 1024 + h * 64 + half * 32 + 4 * cg8) = o; }
        }
#undef SCAN_LOAD
        __syncthreads();
    }
}
__device__ void post_tile(const Params& p, unsigned char* ws, int pm, int pn) {
    const int lane = ltid() & 63, wave = ltid() >> 6;
    const bf16_t* Yd = (const bf16_t*)(ws + WS_R1); const bf16_t* Vb = (const bf16_t*)(ws + WS_R2) + (size_t)2 * MALL * 1024;
    bf16_t* YN = (bf16_t*)(ws + WS_R2); const float* bsum = (const float*)(ws + WS_BSUM);
    const int c = pn * 256 + 4 * lane, head = c >> 6;
    float lg[4], lb[4];
#pragma unroll
    for (int e = 0; e < 4; ++e) { lg[e] = p.in[I_LNG][c + e]; lb[e] = p.in[I_LNB][c + e]; }
#pragma unroll 4
    for (int rr = wave; rr < 256; rr += 8) { const int r = pm * 256 + rr;
        const uint2 f = *(const uint2*)(Yd + (size_t)r * 1024 + c), bb = *(const uint2*)(Yd + ((size_t)MLAT + r) * 1024 + c), vv = *(const uint2*)(Vb + (size_t)r * 1024 + c);
        const float y0 = bflo(f.x) + bflo(bb.x), y1 = bfhi(f.x) + bfhi(bb.x), y2 = bflo(f.y) + bflo(bb.y), y3 = bfhi(f.y) + bfhi(bb.y);
        const float mu = row_allsum16(y0 + y1 + y2 + y3) * (1.f / 64.f);
        const float d0 = y0 - mu, d1 = y1 - mu, d2 = y2 - mu, d3 = y3 - mu;
        const float rs = rsqrtf(row_allsum16(d0 * d0 + d1 * d1 + d2 * d2 + d3 * d3) * (1.f / 64.f) + 64e-5f);
        const float bs = 0.5f * (bsum[(size_t)r * 16 + head] + bsum[((size_t)MLAT + r) * 16 + head]);
        uint2 o; o.x = pk2(d0 * rs * lg[0] + lb[0] + bs * bflo(vv.x), d1 * rs * lg[1] + lb[1] + bs * bfhi(vv.x));
        o.y = pk2(d2 * rs * lg[2] + lb[2] + bs * bflo(vv.y), d3 * rs * lg[3] + lb[3] + bs * bfhi(vv.y));
        *(uint2*)(YN + (size_t)r * 1024 + c) = o; }
}
__device__ void post_phase(const Params& p, unsigned char* ws) {
    const int lane = ltid() & 63, gw = blockIdx.x * 8 + (ltid() >> 6), nw = gridDim.x * 8;
    const bf16_t* Yd = (const bf16_t*)(ws + WS_R1); const bf16_t* Vb = (const bf16_t*)(ws + WS_R2) + (size_t)2 * MALL * 1024;
    bf16_t* YN = (bf16_t*)(ws + WS_R2); const float* bsum = (const float*)(ws + WS_BSUM);
    const int c0 = 16 * lane, head = lane >> 2;
    float lg[16], lb[16];
#pragma unroll
    for (int e = 0; e < 16; ++e) { lg[e] = p.in[I_LNG][c0 + e]; lb[e] = p.in[I_LNB][c0 + e]; }
    for (int r = gw; r < MLAT; r += nw) {
        const uint4 f0 = *(const uint4*)(Yd + (size_t)r * 1024 + c0), f1 = *(const uint4*)(Yd + (size_t)r * 1024 + c0 + 8);
        const uint4 b0 = *(const uint4*)(Yd + ((size_t)MLAT + r) * 1024 + c0), b1 = *(const uint4*)(Yd + ((size_t)MLAT + r) * 1024 + c0 + 8);
        const uint4 v0 = *(const uint4*)(Vb + (size_t)r * 1024 + c0), v1 = *(const uint4*)(Vb + (size_t)r * 1024 + c0 + 8);
        const unsigned fu[8] = {f0.x, f0.y, f0.z, f0.w, f1.x, f1.y, f1.z, f1.w}, bu[8] = {b0.x, b0.y, b0.z, b0.w, b1.x, b1.y, b1.z, b1.w}, vu[8] = {v0.x, v0.y, v0.z, v0.w, v1.x, v1.y, v1.z, v1.w};
        float y[16], s = 0.f;
#pragma unroll
        for (int e = 0; e < 8; ++e) { y[2 * e] = bflo(fu[e]) + bflo(bu[e]); y[2 * e + 1] = bfhi(fu[e]) + bfhi(bu[e]); s += y[2 * e] + y[2 * e + 1]; }
        s += __shfl_xor(s, 1, 64); s += __shfl_xor(s, 2, 64);
        const float mu = s * (1.f / 64.f); float q = 0.f;
#pragma unroll
        for (int e = 0; e < 16; ++e) { const float d = y[e] - mu; q += d * d; }
        q += __shfl_xor(q, 1, 64); q += __shfl_xor(q, 2, 64);
        const float rs = rsqrtf(q * (1.f / 64.f) + 64e-5f);
        const float bs = 0.5f * (bsum[(size_t)r * 16 + head] + bsum[((size_t)MLAT + r) * 16 + head]);
        unsigned ou[8];
#pragma unroll
        for (int e = 0; e < 8; ++e) { const float o0 = (y[2 * e] - mu) * rs * lg[2 * e] + lb[2 * e] + bs * bflo(vu[e]), o1 = (y[2 * e + 1] - mu) * rs * lg[2 * e + 1] + lb[2 * e + 1] + bs * bfhi(vu[e]); ou[e] = pk2(o0, o1); }
        *(uint4*)(YN + (size_t)r * 1024 + c0) = make_uint4(ou[0], ou[1], ou[2], ou[3]); *(uint4*)(YN + (size_t)r * 1024 + c0 + 8) = make_uint4(ou[4], ou[5], ou[6], ou[7]);
    }
}

typedef float f2p __attribute__((ext_vector_type(2)));
__device__ __forceinline__ float2 cmul(float2 a, float2 b) {
    const f2p av = {a.x, a.y}, bv = {b.x, b.y}; f2p t, r;
    asm("v_pk_mul_f32 %0, %1, %2 op_sel:[0,0] op_sel_hi:[0,1]" : "=v"(t) : "v"(av), "v"(bv));
    asm("v_pk_fma_f32 %0, %1, %2, %3 op_sel:[1,1,0] op_sel_hi:[1,0,1] neg_lo:[0,1,0]" : "=v"(r) : "v"(av), "v"(bv), "v"(t));
    return make_float2(r.x, r.y);
}
__device__ __forceinline__ float2 cadd(float2 a, float2 b) { return make_float2(a.x + b.x, a.y + b.y); }
__device__ __forceinline__ float2 csub(float2 a, float2 b) { return make_float2(a.x - b.x, a.y - b.y); }
__device__ __forceinline__ int PADX(int a) { return a + ((a >> 6) << 2); }
__device__ __forceinline__ float2 cmulc(float2 a, float2 b) {
    const f2p av = {a.x, a.y}, bv = {b.x, b.y}; f2p t, r;
    asm("v_pk_mul_f32 %0, %1, %2 op_sel:[0,0] op_sel_hi:[0,1] neg_hi:[0,1]" : "=v"(t) : "v"(av), "v"(bv));
    asm("v_pk_fma_f32 %0, %1, %2, %3 op_sel:[1,1,0] op_sel_hi:[1,0,1]" : "=v"(r) : "v"(av), "v"(bv), "v"(t));
    return make_float2(r.x, r.y);
}
__host__ __device__ constexpr float w16r(int m) { return m == 0 ? 1.f : m == 1 ? 0.9238795325112867f : m == 2 ? 0.7071067811865476f : m == 3 ? 0.3826834323650898f : m == 4 ? 0.f : m == 5 ? -0.3826834323650898f : m == 6 ? -0.7071067811865476f : -0.9238795325112867f; }
__host__ __device__ constexpr float w16i(int m) { return m == 0 ? 0.f : m == 1 ? -0.3826834323650898f : m == 2 ? -0.7071067811865476f : m == 3 ? -0.9238795325112867f : m == 4 ? -1.f : m == 5 ? -0.9238795325112867f : m == 6 ? -0.7071067811865476f : -0.3826834323650898f; }
__host__ __device__ constexpr int br4(int r) { return ((r & 1) << 3) | ((r & 2) << 1) | ((r & 4) >> 1) | ((r & 8) >> 3); }
__device__ __forceinline__ void dft16_fwd(float2 (&x)[16]) {
#pragma unroll
    for (int st = 0; st < 4; ++st) {
#pragma unroll
        for (int base = 0; base < 16; base += (16 >> st))
#pragma unroll
            for (int mm = 0; mm < (8 >> st); ++mm) { const int i0 = base + mm, i1 = base + mm + (8 >> st), e = mm << st;
                const float2 a = x[i0], d = csub(x[i0], x[i1]); x[i0] = cadd(a, x[i1]);
                x[i1] = (e == 0) ? d : ((e == 4) ? make_float2(d.y, -d.x) : cmul(d, make_float2(w16r(e), w16i(e)))); }
    }
}
__device__ __forceinline__ void dft16_inv(float2 (&x)[16]) {
#pragma unroll
    for (int st = 3; st >= 0; --st) {
#pragma unroll
        for (int base = 0; base < 16; base += (16 >> st))
#pragma unroll
            for (int mm = 0; mm < (8 >> st); ++mm) { const int i0 = base + mm, i1 = base + mm + (8 >> st), e = mm << st;
                const float2 b0 = x[i1]; const float2 b = (e == 0) ? b0 : ((e == 4) ? make_float2(-b0.y, b0.x) : cmul(b0, make_float2(w16r(e), -w16i(e))));
                const float2 a = x[i0]; x[i0] = cadd(a, b); x[i1] = csub(a, b); }
    }
}
__device__ __forceinline__ void twid_powers(float2 w, float2 (&pw)[16]) {
    pw[0] = make_float2(1.f, 0.f); pw[1] = w; pw[2] = cmul(w, w); pw[3] = cmul(pw[2], w); pw[4] = cmul(pw[2], pw[2]); pw[5] = cmul(pw[4], w); pw[6] = cmul(pw[3], pw[3]); pw[7] = cmul(pw[4], pw[3]);
    pw[8] = cmul(pw[4], pw[4]);
#pragma unroll
    for (int k = 1; k < 8; ++k) pw[8 + k] = cmul(pw[8], pw[k]);
}
template <int LVL, bool INV> __device__ __forceinline__ void fft16_pass(float2* X, const float2* tA, const float2* tB, int tid) {
    constexpr int n = LVL == 0 ? 16384 : (LVL == 1 ? 1024 : 64), sub = n / 16, lsub = LVL == 0 ? 10 : (LVL == 1 ? 6 : 2);
    constexpr int pstep = LVL == 0 ? 1088 : (LVL == 1 ? 68 : 4);
#pragma unroll 2
    for (int q = 0; q < 2; ++q) { const int idx = tid + 512 * q, j = idx & (sub - 1), bb = idx >> lsub, a0 = bb * n + j;
        const int e = j << (4 * LVL);
        float2 pw[16]; twid_powers(cmul(tA[e >> 5], tB[e & 31]), pw);
        float2* Xp = X + PADX(a0);
        float2 x[16];
        if (!INV) {
#pragma unroll
            for (int mm = 0; mm < 16; ++mm) x[mm] = (LVL == 0 && mm >= 8) ? make_float2(0.f, 0.f) : Xp[mm * pstep];
            dft16_fwd(x);
#pragma unroll
            for (int r = 0; r < 16; ++r) Xp[r * pstep] = (r == 0) ? x[0] : cmul(x[r], pw[br4(r)]);
        } else {
#pragma unroll
            for (int r = 0; r < 16; ++r) { const float2 v = Xp[r * pstep]; x[r] = (r == 0) ? v : cmulc(v, pw[br4(r)]); }
            dft16_inv(x);
#pragma unroll
            for (int mm = 0; mm < 16; ++mm) if (!(LVL == 0 && mm >= 8)) Xp[mm * pstep] = x[mm];
        }
    }
}
template <bool INV> __device__ __forceinline__ void fft4_pass(float2* X, int tid) {
#pragma unroll 2
    for (int q = 0; q < 8; ++q) { const int b = tid + 512 * q; float4* p4 = (float4*)(X + PADX(4 * b));
        const float4 u = p4[0], v = p4[1]; const float2 x0 = make_float2(u.x, u.y), x1 = make_float2(u.z, u.w), x2 = make_float2(v.x, v.y), x3 = make_float2(v.z, v.w);
        float2 o0, o1, o2, o3;
        if (!INV) { const float2 t0 = cadd(x0, x2), t2 = csub(x0, x2), t1 = cadd(x1, x3), d = csub(x1, x3), t3 = make_float2(d.y, -d.x);
            o0 = cadd(t0, t1); o1 = csub(t0, t1); o2 = cadd(t2, t3); o3 = csub(t2, t3); }
        else { const float2 t0 = cadd(x0, x1), t1 = csub(x0, x1), t2 = cadd(x2, x3), d = csub(x2, x3), t3 = make_float2(-d.y, d.x);
            o0 = cadd(t0, t2); o2 = csub(t0, t2); o1 = cadd(t1, t3); o3 = csub(t1, t3); }
        p4[0] = make_float4(o0.x, o0.y, o1.x, o1.y); p4[1] = make_float4(o2.x, o2.y, o3.x, o3.y); }
}
__device__ __forceinline__ void fft_fwd(float2* X, const float2* tA, const float2* tB) {
    const int tid = ltid();
    fft16_pass<0, false>(X, tA, tB, tid); __syncthreads();
    fft16_pass<1, false>(X, tA, tB, tid); __syncthreads();
    fft16_pass<2, false>(X, tA, tB, tid); __syncthreads();
    fft4_pass<false>(X, tid); __syncthreads();
}
__device__ __forceinline__ void fft_inv(float2* X, const float2* tA, const float2* tB) {
    const int tid = ltid();
    fft4_pass<true>(X, tid); __syncthreads();
    fft16_pass<2, true>(X, tA, tB, tid); __syncthreads();
    fft16_pass<1, true>(X, tA, tB, tid); __syncthreads();
    fft16_pass<0, true>(X, tA, tB, tid); __syncthreads();
}
__device__ __forceinline__ float2 conv3_pair(const bf16_t* rowp, int t, int lane, float w0, float w1, float w2, float bias) {
    const unsigned c = *(const unsigned*)(rowp + t);
    const unsigned pl = *(const unsigned*)(rowp + (t > 0 ? t - 2 : 0)), pr = *(const unsigned*)(rowp + (t + 2 < 8192 ? t + 2 : t));
    const float p0 = bflo(c), p1 = bfhi(c);
    const float pm = t > 0 ? bfhi(pl) : 0.f, pp = (t + 2 < 8192) ? bflo(pr) : 0.f;
    return make_float2(pm * w0 + p0 * w1 + p1 * w2 + bias, p0 * w0 + p1 * w1 + pp * w2 + bias);
}
__device__ __forceinline__ float4 conv3_quad(const bf16_t* rowp, int t, float w0, float w1, float w2, float bias) {
    const uint2 c = *(const uint2*)(rowp + t);
    const unsigned pl = *(const unsigned*)(rowp + (t > 0 ? t - 2 : 0)), pr = *(const unsigned*)(rowp + (t + 4 < 8192 ? t + 4 : t));
    const float p0 = bflo(c.x), p1 = bfhi(c.x), p2 = bflo(c.y), p3 = bfhi(c.y);
    const float pm = t > 0 ? bfhi(pl) : 0.f, pp = (t + 4 < 8192) ? bflo(pr) : 0.f;
    return make_float4(pm * w0 + p0 * w1 + p1 * w2 + bias, p0 * w0 + p1 * w1 + p2 * w2 + bias, p1 * w0 + p2 * w1 + p3 * w2 + bias, p2 * w0 + p3 * w1 + pp * w2 + bias);
}
#ifndef FFT_PROBE
#define FFT_PROBE 0
#endif
#if FFT_PROBE
#define FFT_SC (1.f / 16384.f / 16384.f)
#else
#define FFT_SC (1.f / 16384.f)
#endif
__device__ void fftconv_phase(const Params& p, unsigned char* ws, float2* X) {
    const int tid = ltid(), lane = tid & 63;
    const bf16_t* PT = (const bf16_t*)(ws + WS_R2); bf16_t* ZT = (bf16_t*)(ws + WS_R1);
    const bf16_t* filtT = (const bf16_t*)(ws + WS_R3);
    float2* zst = (float2*)(ws + WS_R1 + (size_t)MALL * 2048) + (size_t)blockIdx.x * 16384;
    float2* tA = X + 17408; float2* tB = tA + 32;
    const float *cwp = p.in[I_HCW], *cbp = p.in[I_HCB];
    if (tid < 64) { float s, c; const int k = tid < 32 ? 32 * tid : tid - 32; sincospif((float)k / 8192.f, &s, &c); tA[tid] = make_float2(c, -s); }
    float2 Hr[32];
#pragma unroll
    for (int q = 0; q < 32; ++q) Hr[q] = make_float2(0.f, 0.f);
    for (int c = blockIdx.x; c < 1024; c += gridDim.x) {
        const float vw0 = cwp[2048 + c], vw1 = cwp[3072 + 2048 + c], vw2 = cwp[6144 + 2048 + c], vb = cbp[2048 + c];
#pragma unroll 1
        for (int f = 0; f < 2; ++f) {
            const float dl = fabsf(p.in[I_DELTAS][f * 1024 + c]) * (1.f / 8191.f), biasf = p.in[I_HBIAS][f * 1024 + c];
            const bf16_t* fp = filtT + (size_t)(f * 1024 + c) * 8192;
            const float gw0 = cwp[f * 1024 + c], gw1 = cwp[3072 + f * 1024 + c], gw2 = cwp[6144 + f * 1024 + c], gb = cbp[f * 1024 + c];
#pragma unroll 1
            for (int job = 0; job < 3; ++job) {
                const int pr = job - 1;
                const bf16_t* v0p = PT + (size_t)(2048 + c) * 32768 + (size_t)(2 * (pr & 1)) * 8192; const bf16_t* v1p = v0p + 8192;
                const bf16_t* g0p = PT + (size_t)(f * 1024 + c) * 32768 + (size_t)(2 * (pr & 1)) * 8192; const bf16_t* g1p = g0p + 8192;
                __syncthreads();
#pragma unroll 2
                for (int q = 0; q < 4; ++q) { const int t = 4 * (tid + 512 * q); float4 in0, in1;
                    if (job == 0) { const uint2 u = *(const uint2*)(fp + t);
                        in0 = make_float4(bflo(u.x) * __expf(-(float)t * dl) + (t == 0 ? biasf : 0.f), 0.f, bfhi(u.x) * __expf(-(float)(t + 1) * dl), 0.f);
                        in1 = make_float4(bflo(u.y) * __expf(-(float)(t + 2) * dl), 0.f, bfhi(u.y) * __expf(-(float)(t + 3) * dl), 0.f); }
                    else if (f == 0) { const float4 a = conv3_quad(v0p, t, vw0, vw1, vw2, vb), b = conv3_quad(v1p, t, vw0, vw1, vw2, vb); in0 = make_float4(a.x, b.x, a.y, b.y); in1 = make_float4(a.z, b.z, a.w, b.w); }
                    else { in0 = *(const float4*)(zst + pr * 8192 + t); in1 = *(const float4*)(zst + pr * 8192 + t + 2); }
                    float2* xp = X + PADX(t); *(float4*)xp = in0; *(float4*)(xp + 2) = in1;
                    }
                __syncthreads();
#if FFT_PROBE
                if (job != 0) { fft_fwd(X, tA, tB); fft_inv(X, tA, tB); }
#endif
                fft_fwd(X, tA, tB);
                if (job == 0) {
#pragma unroll
                    for (int q = 0; q < 32; ++q) Hr[q] = X[PADX(tid + 512 * q)];
                } else {
#pragma unroll
                    for (int q = 0; q < 32; ++q) { const int i = PADX(tid + 512 * q); X[i] = cmul(X[i], Hr[q]); }
                    __syncthreads();
                    fft_inv(X, tA, tB);
#pragma unroll 2
                    for (int q = 0; q < 4; ++q) { const int t = 4 * (tid + 512 * q); const float2* xp = X + PADX(t); const float4 c0 = *(const float4*)xp, c1 = *(const float4*)(xp + 2);
                        const float4 ga = conv3_quad(g0p, t, gw0, gw1, gw2, gb), gq = conv3_quad(g1p, t, gw0, gw1, gw2, gb);
                        const float a0 = ga.x * (c0.x * FFT_SC), a1 = ga.y * (c0.z * FFT_SC), a2 = ga.z * (c1.x * FFT_SC), a3 = ga.w * (c1.z * FFT_SC);
                        const float b0 = gq.x * (c0.y * FFT_SC), b1 = gq.y * (c0.w * FFT_SC), b2 = gq.z * (c1.y * FFT_SC), b3 = gq.w * (c1.w * FFT_SC);
                        if (f == 0) { *(float4*)(zst + pr * 8192 + t) = make_float4(a0, b0, a1, b1); *(float4*)(zst + pr * 8192 + t + 2) = make_float4(a2, b2, a3, b3); }
                        else { *(uint2*)(ZT + (size_t)c * 32768 + (size_t)(2 * pr) * 8192 + t) = make_uint2(pk2(a0, a1), pk2(a2, a3)); *(uint2*)(ZT + (size_t)c * 32768 + (size_t)(2 * pr + 1) * 8192 + t) = make_uint2(pk2(b0, b1), pk2(b2, b3)); } }
                }
            }
        }
    }
}
__device__ void transpose_phase(const bf16_t* ZT, bf16_t* Z, unsigned short* tile) {
    const int tid = ltid(), hi = tid >> 3, lo = tid & 7;
    for (int t = blockIdx.x; t < 8192; t += gridDim.x) {
        const int c0 = (t & 15) * 64, t0 = (t >> 4) * 64;
        { const uint4 v = *(const uint4*)(ZT + (size_t)(c0 + hi) * 32768 + t0 + 8 * lo);
          *(uint2*)(tile + hi * 68 + 8 * lo) = make_uint2(v.x, v.y); *(uint2*)(tile + hi * 68 + 8 * lo + 4) = make_uint2(v.z, v.w); }
        __syncthreads();
        { unsigned short x[8];
#pragma unroll
          for (int e = 0; e < 8; ++e) x[e] = tile[(8 * lo + e) * 68 + hi];
          *(uint4*)(Z + (size_t)(t0 + hi) * 1024 + c0 + 8 * lo) = make_uint4((unsigned)x[0] | ((unsigned)x[1] << 16), (unsigned)x[2] | ((unsigned)x[3] << 16), (unsigned)x[4] | ((unsigned)x[5] << 16), (unsigned)x[6] | ((unsigned)x[7] << 16)); }
        __syncthreads();
    }
}
constexpr int S2_NCH = 528, S2_NR = 132;
constexpr int S2_BUF = 11520, S2_SCR = 9472, S2_WL = 8192;
constexpr int PTK = 72, PKT = 20;
constexpr int S2_OFF_SCR = 8 * S2_BUF, S2_OFF_W2 = S2_OFF_SCR + 4 * S2_SCR, S2_OFF_A2 = S2_OFF_W2 + S2_WL, S2_LDS_END = S2_OFF_A2 + S2_WL;
static_assert(S2_LDS_END <= LDS_BYTES - 16, "scan LDS footprint");
constexpr int CB_AP = 0, CB_RT = 2304, CB_BT = 4608, CB_KT = 7168, CB_MAKT = 9728, CB_MRBT = 10240, CB_MRKT = 10752, CB_GC = 11264;
constexpr int SC_A = 0, SC_B = 2304, SC_K = 4608, SC_ATR = 6912, SC_RAWK = SC_A, SC_RAWR = SC_ATR;
__device__ __forceinline__ int s2_tokrow(int ci, int slot, int dir, int b) {
    if (ci < 16) { const int s = ci * 16 + slot; return MLAT + b * 256 + (dir ? 255 - s : s); }
    const int s = (ci - 16) * 16 + slot; return b * 8192 + (dir ? 8191 - s : s);
}
__device__ __forceinline__ uint2 pk4(float a, float b, float c, float d) { uint2 o; o.x = pk2(a, b); o.y = pk2(c, d); return o; }
__device__ __forceinline__ bf16x8 mk8(uint2 lo, uint2 hi) { union { uint4 u; bf16x8 v; } x; x.u = make_uint4(lo.x, lo.y, hi.x, hi.y); return x.v; }
#define S2_WAVE_SYNC() asm volatile("s_waitcnt lgkmcnt(0)" ::: "memory")
__device__ void scan_phase2(const Params& p, unsigned char* ws, unsigned char* L) {
    const int tid = ltid(), lane = tid & 63, wave = tid >> 6, l15 = lane & 15, lq = lane >> 4;
    const bf16_t* Rb = (const bf16_t*)(ws + WS_R2); const bf16_t* Kb = Rb + (size_t)MALL * 1024; const bf16_t* Vb = Kb + (size_t)MALL * 1024;
    const bf16_t* L1w = (const bf16_t*)(ws + WS_R3); const bf16_t* L1a = L1w + (size_t)MALL * 128;
    bf16_t* Yd = (bf16_t*)(ws + WS_R1);
    float* bsum = (float*)(ws + WS_BSUM);
    const f32x4 zero4 = {0.f, 0.f, 0.f, 0.f};
    for (int wi = blockIdx.x; wi < 256; wi += gridDim.x) {
        int chain = wi >> 1, half = wi & 1;
        if (gridDim.x == 256) { const int xcd = wi & 7, jj2 = wi >> 3; chain = xcd * 16 + (jj2 >> 1); half = jj2 & 1; }
        const int dir = chain >> 6, b = (chain >> 4) & 3, h = chain & 15;
        __syncthreads();
        for (int i = tid; i < 2 * 64 * 8; i += NT) { const int which = i >> 9, n = (i >> 3) & 63, seg = i & 7;
            const bf16_t* src = (const bf16_t*)(ws + (which ? WS_A2T : WS_W2T)) + (size_t)(dir * 1024 + h * 64 + n) * 64 + seg * 8;
            *(uint4*)(L + (which ? S2_OFF_A2 : S2_OFF_W2) + n * 128 + ((seg ^ (n & 7)) * 16)) = *(const uint4*)src; }
        __syncthreads();
        if (wave < 2) {
            const int vt = 2 * half + wave, vcol = h * 64 + 16 * vt + l15;
            f32x4 acc[4] = {zero4, zero4, zero4, zero4};
            unsigned short vn[4][4];
#pragma unroll
            for (int q = 0; q < 4; ++q)
#pragma unroll
                for (int jj = 0; jj < 4; ++jj) vn[q][jj] = Vb[(size_t)s2_tokrow(q, 4 * lq + jj, dir, b) * 1024 + vcol];
            for (int R = 0; R <= S2_NR; ++R) {
                unsigned short vc[4][4];
#pragma unroll
                for (int q = 0; q < 4; ++q)
#pragma unroll
                    for (int jj = 0; jj < 4; ++jj) vc[q][jj] = vn[q][jj];
                if (R < S2_NR) {
#pragma unroll
                    for (int q = 0; q < 4; ++q)
#pragma unroll
                        for (int jj = 0; jj < 4; ++jj) vn[q][jj] = Vb[(size_t)s2_tokrow(4 * R + q, 4 * lq + jj, dir, b) * 1024 + vcol];
                }
                if (R >= 1) {
#pragma unroll
                    for (int q = 0; q < 4; ++q) {
                        const int ci = 4 * (R - 1) + q;
                        const unsigned char* cb = L + (((R - 1) & 1) * 4 + q) * S2_BUF;
                        const uint2 vpk = make_uint2((unsigned)vc[q][0] | ((unsigned)vc[q][1] << 16), (unsigned)vc[q][2] | ((unsigned)vc[q][3] << 16));
                        bf16x8 Sb[2];
#pragma unroll
                        for (int ks = 0; ks < 2; ++ks) Sb[ks] = mk8(pk4(acc[2 * ks][0], acc[2 * ks][1], acc[2 * ks][2], acc[2 * ks][3]), pk4(acc[2 * ks + 1][0], acc[2 * ks + 1][1], acc[2 * ks + 1][2], acc[2 * ks + 1][3]));
                        f32x4 UT = zero4;
#pragma unroll
                        for (int ks = 0; ks < 2; ++ks) { const bf16x8 af = mk8(*(const uint2*)(cb + CB_AP + (l15 * PTK + 32 * ks + 4 * lq) * 2), *(const uint2*)(cb + CB_AP + (l15 * PTK + 32 * ks + 16 + 4 * lq) * 2));
                            UT = __builtin_amdgcn_mfma_f32_16x16x32_bf16(af, Sb[ks], UT, 0, 0, 0); }
                        UT = __builtin_amdgcn_mfma_f32_16x16x32_bf16(mk8(*(const uint2*)(cb + CB_MAKT + (l15 * 16 + 4 * lq) * 2), make_uint2(0u, 0u)), mk8(vpk, make_uint2(0u, 0u)), UT, 0, 0, 0);
                        const bf16x8 UVb = mk8(pk4(UT[0], UT[1], UT[2], UT[3]), vpk);
                        f32x4 YT = zero4;
#pragma unroll
                        for (int ks = 0; ks < 2; ++ks) { const bf16x8 rf = mk8(*(const uint2*)(cb + CB_RT + (l15 * PTK + 32 * ks + 4 * lq) * 2), *(const uint2*)(cb + CB_RT + (l15 * PTK + 32 * ks + 16 + 4 * lq) * 2));
                            YT = __builtin_amdgcn_mfma_f32_16x16x32_bf16(rf, Sb[ks], YT, 0, 0, 0); }
                        YT = __builtin_amdgcn_mfma_f32_16x16x32_bf16(mk8(*(const uint2*)(cb + CB_MRBT + (l15 * 16 + 4 * lq) * 2), *(const uint2*)(cb + CB_MRKT + (l15 * 16 + 4 * lq) * 2)), UVb, YT, 0, 0, 0);
                        if (ci >= 16) {
#pragma unroll
                            for (int jj = 0; jj < 4; ++jj) Yd[((size_t)dir * MLAT + s2_tokrow(ci, 4 * lq + jj, dir, b)) * 1024 + vcol] = (bf16_t)(pk2(YT[jj], 0.f) & 0xffffu);
                        }
#pragma unroll
                        for (int kt = 0; kt < 4; ++kt) { const bf16x8 bkf = mk8(*(const uint2*)(cb + CB_BT + ((16 * kt + l15) * PKT + 4 * lq) * 2), *(const uint2*)(cb + CB_KT + ((16 * kt + l15) * PKT + 4 * lq) * 2));
                            acc[kt] = __builtin_amdgcn_mfma_f32_16x16x32_bf16(bkf, UVb, acc[kt], 0, 0, 0);
                            const float4 g = *(const float4*)(cb + CB_GC + (16 * kt + 4 * lq) * 4);
                            acc[kt][0] *= g.x; acc[kt][1] *= g.y; acc[kt][2] *= g.z; acc[kt][3] *= g.w; }
                    }
                }
                __syncthreads();
            }
        } else if (wave < 6) {
            const int hw = wave - 2;
            unsigned char* sc = L + S2_OFF_SCR + hw * S2_SCR;
            float w0v[4], a0v[4], kkc[4], kac[4], rkc[4];
#pragma unroll
            for (int nt = 0; nt < 4; ++nt) { const int ch = h * 64 + 16 * nt + l15; w0v[nt] = p.in[I_W0][dir * 1024 + ch]; a0v[nt] = p.in[I_A0][dir * 1024 + ch]; kkc[nt] = p.in[I_KK][ch]; kac[nt] = p.in[I_KA][ch]; rkc[nt] = p.in[I_RK][ch]; }
            const int tt = lane >> 2, cgp = (lane & 3) * 16;
            bf16x8 paw[2], paa[2]; uint4 rk0, rk1, rr0, rr1;
#define S2_LOAD(ci) do { const int _ra = s2_tokrow((ci), l15, dir, b); \
                paw[0] = *(const bf16x8*)(L1w + (size_t)_ra * 128 + dir * 64 + lq * 8); paw[1] = *(const bf16x8*)(L1w + (size_t)_ra * 128 + dir * 64 + 32 + lq * 8); \
                paa[0] = *(const bf16x8*)(L1a + (size_t)_ra * 128 + dir * 64 + lq * 8); paa[1] = *(const bf16x8*)(L1a + (size_t)_ra * 128 + dir * 64 + 32 + lq * 8); \
                const size_t _rb = (size_t)s2_tokrow((ci), tt, dir, b) * 1024 + h * 64 + cgp; \
                rk0 = *(const uint4*)(Kb + _rb); rk1 = *(const uint4*)(Kb + _rb + 8); rr0 = *(const uint4*)(Rb + _rb); rr1 = *(const uint4*)(Rb + _rb + 8); } while (0)
            S2_LOAD(hw);
            for (int R = 0; R <= S2_NR; ++R) {
                if (R < S2_NR) {
                    const int ci = 4 * R + hw;
                    unsigned char* cb = L + ((R & 1) * 4 + hw) * S2_BUF;
                    *(uint4*)(sc + SC_RAWK + (tt * 64 + cgp) * 2) = rk0; *(uint4*)(sc + SC_RAWK + (tt * 64 + cgp + 8) * 2) = rk1;
                    *(uint4*)(sc + SC_RAWR + (tt * 64 + cgp) * 2) = rr0; *(uint4*)(sc + SC_RAWR + (tt * 64 + cgp + 8) * 2) = rr1;
                    f32x4 lwv[4], avv[4];
#pragma unroll
                    for (int nt = 0; nt < 4; ++nt) { const int rb = (16 * nt + l15) * 128, o0 = rb + ((lq ^ (l15 & 7)) * 16), o1 = rb + (((4 + lq) ^ (l15 & 7)) * 16);
                        const bf16x8 bw0 = *(const bf16x8*)(L + S2_OFF_W2 + o0), bw1 = *(const bf16x8*)(L + S2_OFF_W2 + o1), ba0 = *(const bf16x8*)(L + S2_OFF_A2 + o0), ba1 = *(const bf16x8*)(L + S2_OFF_A2 + o1);
                        lwv[nt] = __builtin_amdgcn_mfma_f32_16x16x32_bf16(paw[0], bw0, zero4, 0, 0, 0); lwv[nt] = __builtin_amdgcn_mfma_f32_16x16x32_bf16(paw[1], bw1, lwv[nt], 0, 0, 0);
                        avv[nt] = __builtin_amdgcn_mfma_f32_16x16x32_bf16(paa[0], ba0, zero4, 0, 0, 0); avv[nt] = __builtin_amdgcn_mfma_f32_16x16x32_bf16(paa[1], ba1, avv[nt], 0, 0, 0); }
                    if (4 * (R + 1) + hw < S2_NCH) S2_LOAD(4 * (R + 1) + hw);
                    float ev[4][4], epv[4][4];
#pragma unroll
                    for (int nt = 0; nt < 4; ++nt) {
                        float cl[4], run = 0.f;
#pragma unroll
                        for (int j = 0; j < 4; ++j) { const float lw = -0.60653065971263342f * sigm(w0v[nt] + lwv[nt][j]); run += lw; cl[j] = run; avv[nt][j] = sigm(a0v[nt] + avv[nt][j]); }
                        float x = run; const float y1 = __shfl_up(x, 16, 64); x += (lq >= 1) ? y1 : 0.f; const float y2 = __shfl_up(x, 32, 64); x += (lq >= 2) ? y2 : 0.f;
                        const float off = x - run;
                        float prev = __expf(off);
#pragma unroll
                        for (int j = 0; j < 4; ++j) { epv[nt][j] = prev; prev = __expf(cl[j] + off); ev[nt][j] = prev; }
                        if (lq == 3) *(float*)(cb + CB_GC + (4 * l15 + nt) * 4) = ev[nt][3];
                    }
                    S2_WAVE_SYNC();
                    float kv[4][4], rv[4][4], ss[4] = {0.f, 0.f, 0.f, 0.f};
#pragma unroll
                    for (int nt = 0; nt < 4; ++nt)
#pragma unroll
                        for (int j = 0; j < 4; ++j) { const int o = ((4 * lq + j) * 64 + 16 * nt + l15) * 2; kv[nt][j] = bf2f(*(const unsigned short*)(sc + SC_RAWK + o)); rv[nt][j] = bf2f(*(const unsigned short*)(sc + SC_RAWR + o));
                            const float kr = kv[nt][j] * kkc[nt]; ss[j] += kr * kr; }
                    float rn[4], bp[4] = {0.f, 0.f, 0.f, 0.f};
#pragma unroll
                    for (int j = 0; j < 4; ++j) rn[j] = __builtin_amdgcn_rsqf(fmaxf(row_allsum16(ss[j]), 1e-24f));
                    S2_WAVE_SYNC();
                    float atv[4][4], btv[4][4], ktv[4][4];
#pragma unroll
                    for (int nt = 0; nt < 4; ++nt)
#pragma unroll
                        for (int j = 0; j < 4; ++j) { const float a = avv[nt][j], kk = kv[nt][j] * kkc[nt] * rn[j], kd = kv[nt][j] * (1.f + (a - 1.f) * kac[nt]), ei = frcp(ev[nt][j]);
                            atv[nt][j] = -kk * epv[nt][j]; btv[nt][j] = kk * a * ei; ktv[nt][j] = kd * ei; bp[j] += rv[nt][j] * kd * rkc[nt]; rv[nt][j] *= ev[nt][j]; }
#pragma unroll
                    for (int j = 0; j < 4; ++j) { const float bs = row_allsum16(bp[j]); if (ci >= 16 && half == 0 && l15 == 0) bsum[((size_t)dir * MLAT + s2_tokrow(ci, 4 * lq + j, dir, b)) * 16 + h] = bs; }
#pragma unroll
                    for (int j = 0; j < 4; ++j) { const int o = ((4 * lq + j) * PTK + 4 * l15) * 2;
                        *(uint2*)(sc + SC_A + o) = pk4(atv[0][j], atv[1][j], atv[2][j], atv[3][j]); *(uint2*)(cb + CB_RT + o) = pk4(rv[0][j], rv[1][j], rv[2][j], rv[3][j]);
                        *(uint2*)(sc + SC_B + o) = pk4(btv[0][j], btv[1][j], btv[2][j], btv[3][j]); *(uint2*)(sc + SC_K + o) = pk4(ktv[0][j], ktv[1][j], ktv[2][j], ktv[3][j]); }
#pragma unroll
                    for (int nt = 0; nt < 4; ++nt) { const int o = ((4 * l15 + nt) * PKT + 4 * lq) * 2;
                        *(uint2*)(sc + SC_ATR + o) = pk4(atv[nt][0], atv[nt][1], atv[nt][2], atv[nt][3]);
                        *(uint2*)(cb + CB_BT + o) = pk4(btv[nt][0], btv[nt][1], btv[nt][2], btv[nt][3]); *(uint2*)(cb + CB_KT + o) = pk4(ktv[nt][0], ktv[nt][1], ktv[nt][2], ktv[nt][3]); }
                    S2_WAVE_SYNC();
                    f32x4 mab = zero4, mak = zero4, mrb = zero4, mrk = zero4, mabT = zero4, makT = zero4;
#pragma unroll
                    for (int ks = 0; ks < 2; ++ks) { const int o = (l15 * PTK + 32 * ks + 8 * lq) * 2;
                        const bf16x8 bf = *(const bf16x8*)(sc + SC_B + o), kf = *(const bf16x8*)(sc + SC_K + o), af = *(const bf16x8*)(sc + SC_A + o), rf = *(const bf16x8*)(cb + CB_RT + o);
                        mab = __builtin_amdgcn_mfma_f32_16x16x32_bf16(bf, af, mab, 0, 0, 0); mak = __builtin_amdgcn_mfma_f32_16x16x32_bf16(kf, af, mak, 0, 0, 0);
                        mrb = __builtin_amdgcn_mfma_f32_16x16x32_bf16(bf, rf, mrb, 0, 0, 0); mrk = __builtin_amdgcn_mfma_f32_16x16x32_bf16(kf, rf, mrk, 0, 0, 0);
                        mabT = __builtin_amdgcn_mfma_f32_16x16x32_bf16(af, bf, mabT, 0, 0, 0); makT = __builtin_amdgcn_mfma_f32_16x16x32_bf16(af, kf, makT, 0, 0, 0); }
#pragma unroll
                    for (int j = 0; j < 4; ++j) { const int i = 4 * lq + j; if (!(i < l15)) { mab[j] = 0.f; mak[j] = 0.f; } if (!(i <= l15)) { mrb[j] = 0.f; mrk[j] = 0.f; }
                        if (!(l15 < i)) { mabT[j] = 0.f; makT[j] = 0.f; } }
                    *(uint2*)(cb + CB_MRBT + (l15 * 16 + 4 * lq) * 2) = pk4(mrb[0], mrb[1], mrb[2], mrb[3]);
                    *(uint2*)(cb + CB_MRKT + (l15 * 16 + 4 * lq) * 2) = pk4(mrk[0], mrk[1], mrk[2], mrk[3]);
                    f32x4 G = mab, P = mab, PT = mabT;
                    const uint2 z2 = make_uint2(0u, 0u);
#pragma unroll
                    for (int it = 0; it < 4; ++it) {
                        const bf16x8 aP = mk8(pk4(PT[0], PT[1], PT[2], PT[3]), z2);
                        const bf16x8 bG = mk8(pk4(G[0], G[1], G[2], G[3]), z2);
                        G = __builtin_amdgcn_mfma_f32_16x16x32_bf16(aP, bG, G, 0, 0, 0);
                        if (it < 3) { const bf16x8 bP = mk8(pk4(P[0], P[1], P[2], P[3]), z2);
                            const f32x4 Pn = __builtin_amdgcn_mfma_f32_16x16x32_bf16(aP, bP, zero4, 0, 0, 0);
                            const f32x4 PTn = __builtin_amdgcn_mfma_f32_16x16x32_bf16(bP, mk8(pk4(PT[0], PT[1], PT[2], PT[3]), z2), zero4, 0, 0, 0);
                            P = Pn; PT = PTn; }
                    }
#pragma unroll
                    for (int j = 0; j < 4; ++j) if (4 * lq + j == l15) G[j] += 1.f;
                    {
                        const bf16x8 bT = mk8(pk4(G[0], G[1], G[2], G[3]), z2);
                        const f32x4 makp = __builtin_amdgcn_mfma_f32_16x16x32_bf16(mk8(pk4(makT[0], makT[1], makT[2], makT[3]), z2), bT, zero4, 0, 0, 0);
                        *(uint2*)(cb + CB_MAKT + (l15 * 16 + 4 * lq) * 2) = pk4(makp[0], makp[1], makp[2], makp[3]);
#pragma unroll
                        for (int mt = 0; mt < 4; ++mt) { const bf16x8 aa = mk8(*(const uint2*)(sc + SC_ATR + ((16 * mt + l15) * PKT + 4 * lq) * 2), z2);
                            const f32x4 ap = __builtin_amdgcn_mfma_f32_16x16x32_bf16(aa, bT, zero4, 0, 0, 0);
                            *(uint2*)(cb + CB_AP + (l15 * PTK + 16 * mt + 4 * lq) * 2) = pk4(ap[0], ap[1], ap[2], ap[3]); }
                    }
                }
                __syncthreads();
            }
#undef S2_LOAD
        } else {
            for (int R = 0; R <= S2_NR; ++R) __syncthreads();
        }
    }
}
__device__ void prep_phase(const Params& p, unsigned char* ws, float* ldsf) {
    for (int f = 0; f < 4; ++f) {
        transpose_cvt(FGu{p.in[I_WGU] + (size_t)f * 1024 * 5632}, (bf16_t*)(ws + WS_WGU + f * SZ_WGU), 5632, 1024, ldsf);
        transpose_cvt(FPlain{p.in[I_WDN] + (size_t)f * 2816 * 1024, 1024}, (bf16_t*)(ws + WS_WDN + f * SZ_WDN), 1024, 2816, ldsf);
    }
    transpose_cvt(FRw{p.in[I_WRKV], p.in[I_W1], p.in[I_A1], p.in[I_G1], p.in[I_MIX]}, (bf16_t*)(ws + WS_WRW), 3584, 2048, ldsf);
    transpose_cvt(FG2{p.in[I_G2]}, (bf16_t*)(ws + WS_WG2), 1024, 256, ldsf);
    transpose_cvt(FPlain{p.in[I_WO], 1024}, (bf16_t*)(ws + WS_WO), 1024, 1024, ldsf);
    transpose_cvt(FLora2{p.in[I_W2]}, (bf16_t*)(ws + WS_W2T), 2048, 64, ldsf);
    transpose_cvt(FLora2{p.in[I_A2]}, (bf16_t*)(ws + WS_A2T), 2048, 64, ldsf);
    transpose_cvt(FPlain{p.in[I_HWIN], 3072}, (bf16_t*)(ws + WS_WIN), 3072, 1024, ldsf);
    transpose_cvt(FPlain{p.in[I_HWOUT], 1024}, (bf16_t*)(ws + WS_WOUT), 1024, 1024, ldsf);
    mod_phase(p, (float*)(ws + WS_MOD), ldsf);
    __syncthreads();
    hid_phase(p, (bf16_t*)(ws + WS_HID2), ldsf);
    __syncthreads();
    transpose_cvt(FW3{p.in[I_FW3]}, (bf16_t*)(ws + WS_W3T), 2048, 256, ldsf);
}

#ifndef DUP_SCAN
#define DUP_SCAN 0
#endif
#ifndef DUP_FFT
#define DUP_FFT 0
#endif
#ifndef DUP_PREP
#define DUP_PREP 0
#endif
#ifndef DUP_GU
#define DUP_GU 0
#endif
#ifndef DUP_SYNC
#define DUP_SYNC 0
#endif
typedef const __attribute__((address_space(4))) Params* CParamsPtr;
__device__ __forceinline__ const Params& kparams() {
    unsigned long long v = (unsigned long long)__builtin_amdgcn_kernarg_segment_ptr();
    asm volatile("" : "+s"(v));
    return *(const Params*)(CParamsPtr)v;
}
#define PH_BEGIN { const Params& p = kparams(); unsigned char* ws = p.ws; float* xl = p.out; float* xc = (float*)(ws + WS_XC); const float* mod0 = (const float*)(ws + WS_MOD); const float* mod1 = mod0 + 5 * 9216; \
    const float* ng = p.in[I_NORMG]; bf16_t* R1 = (bf16_t*)(ws + WS_R1); bf16_t* R2 = (bf16_t*)(ws + WS_R2); bf16_t* R3 = (bf16_t*)(ws + WS_R3); \
    const bf16_t* WGU = (const bf16_t*)(ws + WS_WGU); const bf16_t* WDN = (const bf16_t*)(ws + WS_WDN); const size_t EGU = SZ_WGU / 2, EDN = SZ_WDN / 2; \
    (void)xl; (void)xc; (void)mod0; (void)mod1; (void)ng; (void)R1; (void)R2; (void)R3; (void)WGU; (void)WDN; (void)EGU; (void)EDN;

__global__ void __launch_bounds__(NT, 2) fwd_megakernel(Params p_unused) {
    extern __shared__ __attribute__((aligned(16))) unsigned char lds_raw[];
    cg::grid_group grid = cg::this_grid();
    LAS unsigned char* lds = (LAS unsigned char*)lds_raw;
    float* ldsf = (float*)lds_raw;
    volatile LAS unsigned* xb_st = (volatile LAS unsigned*)(lds + (LDS_BYTES - 16));
    if (threadIdx.x < 4) xb_st[threadIdx.x] = 0u;
    __syncthreads();
    { const Params& p = kparams();
      if (blockIdx.x == 0) for (int i = threadIdx.x; i < XCD_BAR_WORDS; i += NT) ((unsigned*)(p.ws + WS_BAR))[i] = 0u;
      prep_phase(p, p.ws, ldsf); }
    grid.sync();
    XcdBarrier xbar; { const Params& p0 = kparams(); xbar = xcd_barrier_post((unsigned*)(p0.ws + WS_BAR), xb_st); }
#pragma unroll 1
    for (int ph = 0; ph < 23; ++ph) {
        PH_BEGIN
        switch (ph) {
        case 0: case 3: case 9: case 12: case 15: case 20: {
            const int li = ph >= 12, sub = (ph == 0 || ph == 12) ? 0 : ((ph == 3 || ph == 15) ? 1 : 2);
            prenorm_phase(ph == 0 ? p.in[I_X] : xl, ph == 0 ? p.in[I_CTX] : xc, ng + (li * 3 + sub) * 1024, li ? mod1 : mod0, 3 * sub, 3 * sub + 1, R1, ph == 3 ? 2048 : 1024, (ph == 0 || ph == 3) ? MALL : MLAT); } break;
        case 1: case 10: case 13: case 21: {
            const int f = ph == 1 ? 0 : (ph == 10 ? 1 : (ph == 13 ? 2 : 3));
            run_gemm(lds, R1, WGU + f * EGU, f == 0 ? MALL : MLAT, 5632, 1024, EpiSwiglu{R2}); } break;
        case 2: case 11: case 14: case 22: {
            const int f = ph == 2 ? 0 : (ph == 11 ? 1 : (ph == 14 ? 2 : 3));
            run_gemm(lds, R2, WDN + f * EDN, f == 0 ? MALL : MLAT, 1024, 2816, EpiResid{f == 0 ? p.in[I_X] : xl, xl, f == 0 ? p.in[I_CTX] : xc, xc, f < 2 ? mod0 : mod1, (f & 1) ? 8 : 2, 0.5f}); } break;
        case 4: dshift_phase(R1); break;
        case 5: run_gemm(lds, R1, (const bf16_t*)(ws + WS_WRW), MALL, 3584, 2048, EpiRwkv{R2, R3}); break;
        case 6: scan_phase2(p, ws, lds_raw); break;
        case 7: {
            pg8::StaticOrder S; S.init(MLAT, 1024, (int)gridDim.x, (int)blockIdx.x); Unit u;
            for (int i = 0; S.next(i, u); ++i) post_tile(p, ws, u.pm, u.pn);
            __syncthreads();
            run_gemm(lds, R3 + (size_t)MALL * 256, (const bf16_t*)(ws + WS_WG2), MLAT, 1024, 256, EpiG{R2, R2 + (size_t)MALL * 1024}); } break;
        case 8: case 19: {
            const bool hy = ph == 19;
            run_gemm(lds, hy ? R2 : R2 + (size_t)MALL * 1024, (const bf16_t*)(ws + (hy ? WS_WOUT : WS_WO)), MLAT, 1024, 1024, EpiResid{xl, xl, xc, xc, hy ? mod1 : mod0, 5, 1.0f}); } break;
        case 16: {
            run_gemm(lds, (const bf16_t*)(ws + WS_WIN), R1, 3072, MLAT, 1024, EpiBf16Plain{R2, MLAT});
            run_gemm(lds, (const bf16_t*)(ws + WS_W3T), (const bf16_t*)(ws + WS_HID2), 2048, 8192, 256, EpiBf16Plain{R3, 8192}); } break;
        case 17: fftconv_phase(p, ws, (float2*)lds_raw); break;
        case 18: transpose_phase(R1, R2, (unsigned short*)lds_raw); break;
        default: break;
        }
        }
        xcd_barrier(xbar);
    }
    { const Params& p = kparams(); final_norm_phase(p.out, p.in[I_FINALG]); }
}

extern "C" void kernel_launch(void* const* d_in, const int* in_sizes, int n_in, void* d_out, int out_size, void* d_ws, size_t ws_size, hipStream_t stream) {
    static int grid = 0;
    if (grid == 0) {
        if (n_in != 38 || ws_size < WS_END) { fprintf(stderr, "kernel_launch: unexpected n_in %d or ws_size %zu (< %zu)\n", n_in, ws_size, (size_t)WS_END); grid = -1; return; }
        int dev = 0, cus = 0, per_cu = 0;
        (void)hipGetDevice(&dev);
        (void)hipDeviceGetAttribute(&cus, hipDeviceAttributeMultiprocessorCount, dev);
        (void)hipFuncSetAttribute((const void*)fwd_megakernel, hipFuncAttributeMaxDynamicSharedMemorySize, LDS_BYTES);
        (void)hipOccupancyMaxActiveBlocksPerMultiprocessor(&per_cu, (const void*)fwd_megakernel, NT, LDS_BYTES);
        if (per_cu < 1) { fprintf(stderr, "kernel_launch: occupancy query says %d blocks/CU\n", per_cu); per_cu = 1; }
        (void)hipGetLastError();
        grid = cus;
    }
    if (grid < 0) return;
    Params p{};
    for (int i = 0; i < 38; ++i) p.in[i] = (const float*)d_in[i];
    p.out = (float*)d_out; p.ws = (unsigned char*)d_ws;
    void* args[] = {&p};
    hipError_t e = hipLaunchCooperativeKernel((void*)fwd_megakernel, dim3(grid), dim3(NT), args, LDS_BYTES, stream);
    if (e != hipSuccess) fprintf(stderr, "cooperative launch failed: %s (grid %d)\n", hipGetErrorString(e), grid);
}
```
